# Optimizing an MI355X kernel written in HIP

```python
import math
import jax, jax.numpy as jnp
from jax import lax
import numpy as np

D_MODEL = 1024
BATCH = 8
SEQ = 2048
DEPTH = 1
DEC_BATCH = 128
DEC_SEQ = 4
PAST_LEN = 2048
PAGE_SIZE = 128

N_HEADS_SB = 8
HEAD_DIM = 64
SB_WIDTH = N_HEADS_SB * HEAD_DIM
SB_SCALE = HEAD_DIM ** -0.5
SB_BIAS_INIT = -8.0
Q_BLOCK = 128
N_HEADS_HG = 8
HG_KEY_DIM = 64
HG_VAL_DIM = 64
HG_QK = N_HEADS_HG * HG_KEY_DIM
HG_V = N_HEADS_HG * HG_VAL_DIM
HG_CHUNK = 64
MIX_WIDTH = SB_WIDTH + HG_V
N_IN = 3 * SB_WIDTH + 2 * HG_QK + 2 * HG_V
SPLITS = (SB_WIDTH, 2 * SB_WIDTH, 3 * SB_WIDTH, 3 * SB_WIDTH + HG_QK,
          3 * SB_WIDTH + 2 * HG_QK, 3 * SB_WIDTH + 2 * HG_QK + HG_V)
D_FF = 4 * D_MODEL
N_ADA = 6
EPS = 1e-6
F32 = jnp.float32

kernel_name = "hymba_stickbreak_hgrn2_step"


def rms_norm(x, g):
    xf = x.astype(F32)
    y = xf * lax.rsqrt(jnp.mean(xf * xf, axis=-1, keepdims=True) + EPS)
    return (y * g.astype(F32)).astype(x.dtype)


def stick_breaking(q, k, v, q_pos, bias):
    z = jnp.einsum('bthd,bshd->bhts', q.astype(F32), k.astype(F32)) * SB_SCALE \
        + bias.astype(F32)[None, :, None, None]
    valid = jnp.arange(k.shape[1])[None, :] < q_pos[:, None]
    log_1m = jnp.where(valid, jax.nn.log_sigmoid(-z), 0.0)
    rev = lax.cumsum(log_1m, axis=3, reverse=True)
    tail = jnp.concatenate([rev[..., 1:], jnp.zeros_like(rev[..., :1])], axis=-1)
    w = jnp.where(valid, jnp.exp(jax.nn.log_sigmoid(z) + tail), 0.0)
    return jnp.einsum('bhts,bshd->bthd', w, v.astype(F32))


def hgrn2_chunked(q, k, v, log_f, s0):
    B, T, H, DK = q.shape
    C = math.gcd(T, HG_CHUNK)
    n = T // C
    rs = lambda a: a.reshape(B, n, C, H, a.shape[-1])
    q, k, v, g = rs(q), rs(k), rs(v), rs(log_f)
    b = jnp.cumsum(g, axis=2)
    b_last = b[:, :, -1:]
    q_dec = q * jnp.exp(b)
    k_dec = k * jnp.exp(-b)
    causal = jnp.tril(jnp.ones((C, C), dtype=bool))
    att = jnp.where(causal, jnp.einsum('bnthk,bnshk->bnhts', q_dec, k_dec), 0.0)
    o_intra = jnp.einsum('bnhts,bnshv->bnthv', att, v)
    d_state = jnp.einsum('bnshk,bnshv->bnhkv', k * jnp.exp(b_last - b), v)
    decay = jnp.exp(b_last[:, :, 0])

    def step(S, inp):
        dS, dec = inp
        return dec[..., None] * S + dS, S

    s_final, s_start = lax.scan(step, s0, (jnp.swapaxes(d_state, 0, 1), jnp.swapaxes(decay, 0, 1)))
    s_start = jnp.swapaxes(s_start, 0, 1)
    o_inter = jnp.einsum('bnthk,bnhkv->bnthv', q_dec, s_start)
    return (o_intra + o_inter).reshape(B, T, H, v.shape[-1]), s_final


def decoder_layer(x, c, w_ada, b_ada, n1, n2, w_in, qg, kg, sb_b, lb, hg_out_g, w_out, w_up, w_down,
                  k_past, v_past, s0):
    B, T, _ = x.shape
    ada = (jax.nn.silu(c) @ w_ada + b_ada)[:, None, :]
    sh1, sc1, g1, sh2, sc2, g2 = jnp.split(ada, N_ADA, axis=-1)
    h = rms_norm(x, n1) * (1 + sc1) + sh1
    proj = h @ w_in
    q_a, k_a, v_a, q_b, f_b, i_b, g_b = jnp.split(proj, SPLITS, axis=-1)
    q_a = rms_norm(q_a.reshape(B, T, N_HEADS_SB, HEAD_DIM), qg)
    k_a = rms_norm(k_a.reshape(B, T, N_HEADS_SB, HEAD_DIM), kg)
    v_a = v_a.reshape(B, T, N_HEADS_SB, HEAD_DIM)
    if k_past is None:
        nb = T // Q_BLOCK
        qb = jnp.swapaxes(q_a.reshape(B, nb, Q_BLOCK, N_HEADS_SB, HEAD_DIM), 0, 1)
        pos = jnp.arange(T).reshape(nb, Q_BLOCK)
        o_a = lax.map(lambda a: stick_breaking(a[0], k_a, v_a, a[1], sb_b), (qb, pos))
        o_a = jnp.swapaxes(o_a, 0, 1).reshape(B, T, SB_WIDTH)
    else:
        P = k_past.shape[1]
        k_all = jnp.concatenate([k_past.astype(k_a.dtype), k_a], axis=1)
        v_all = jnp.concatenate([v_past.astype(v_a.dtype), v_a], axis=1)
        o_a = stick_breaking(q_a, k_all, v_all, P + jnp.arange(T), sb_b).reshape(B, T, SB_WIDTH)
    f = lb + (1.0 - lb) * jax.nn.sigmoid(f_b.astype(F32))
    hq = jax.nn.silu(q_b.astype(F32)).reshape(B, T, N_HEADS_HG, HG_KEY_DIM)
    hk = (1.0 - f).reshape(B, T, N_HEADS_HG, HG_KEY_DIM)
    hlog_f = jnp.log(f).reshape(B, T, N_HEADS_HG, HG_KEY_DIM)
    hv = i_b.astype(F32).reshape(B, T, N_HEADS_HG, HG_VAL_DIM)
    o_b, s_new = hgrn2_chunked(hq, hk, hv, hlog_f, s0.astype(F32))
    o_b = rms_norm(o_b, hg_out_g) * jax.nn.silu(g_b.astype(F32)).reshape(B, T, N_HEADS_HG, HG_VAL_DIM)
    mix = jnp.concatenate([o_a.astype(x.dtype), o_b.reshape(B, T, HG_V).astype(x.dtype)], axis=-1) @ w_out
    x = x + g1 * mix
    h2 = rms_norm(x, n2) * (1 + sc2) + sh2
    x = x + g2 * (jnp.square(jax.nn.relu(h2 @ w_up)) @ w_down)
    return x, k_a, v_a, s_new.astype(x.dtype)


def setup_inputs(seed: int = 0) -> dict:
    key = jax.random.key(seed)
    ks = jax.random.split(key, 24)
    n_pages = PAST_LEN // PAGE_SIZE
    n_used = DEC_BATCH * n_pages
    n_phys = n_used + (n_used + 3) // 4
    nrm = lambda k, s, sc=1.0: jax.random.normal(k, s, F32) * sc
    perm = jax.random.permutation(ks[0], n_phys)
    page_table = perm[:n_used].reshape(DEC_BATCH, n_pages).astype(jnp.int32)
    return {
        "x_prompt": nrm(ks[1], (BATCH, SEQ, D_MODEL)),
        "x_sample": nrm(ks[2], (DEC_BATCH, DEC_SEQ, D_MODEL)),
        "cache_k": nrm(ks[3], (DEPTH, n_phys, PAGE_SIZE, N_HEADS_SB, HEAD_DIM)),
        "cache_v": nrm(ks[4], (DEPTH, n_phys, PAGE_SIZE, N_HEADS_SB, HEAD_DIM)),
        "state_hgrn": nrm(ks[5], (DEPTH, DEC_BATCH, N_HEADS_HG, HG_KEY_DIM, HG_VAL_DIM), 0.5),
        "page_table": page_table,
        "c_prompt": nrm(ks[6], (BATCH, D_MODEL)),
        "c_sample": nrm(ks[7], (DEC_BATCH, D_MODEL)),
        "w_ada": nrm(ks[8], (DEPTH, D_MODEL, N_ADA * D_MODEL), D_MODEL ** -0.5),
        "b_ada": nrm(ks[9], (DEPTH, N_ADA * D_MODEL), 0.02),
        "norm1_g": 1.0 + nrm(ks[10], (DEPTH, D_MODEL), 0.02),
        "norm2_g": 1.0 + nrm(ks[11], (DEPTH, D_MODEL), 0.02),
        "w_in": nrm(ks[12], (DEPTH, D_MODEL, N_IN), D_MODEL ** -0.5),
        "q_norm_g": 1.0 + nrm(ks[13], (DEPTH, HEAD_DIM), 0.02),
        "k_norm_g": 1.0 + nrm(ks[14], (DEPTH, HEAD_DIM), 0.02),
        "sb_bias": SB_BIAS_INIT + nrm(ks[20], (DEPTH, N_HEADS_SB), 0.1),
        "hg_lb_logits": nrm(ks[15], (DEPTH + 1, HG_QK), 0.1),
        "hg_out_g": 1.0 + nrm(ks[16], (DEPTH, HG_VAL_DIM), 0.02),
        "w_out": nrm(ks[17], (DEPTH, MIX_WIDTH, D_MODEL), MIX_WIDTH ** -0.5),
        "w_up": nrm(ks[18], (DEPTH, D_MODEL, D_FF), D_MODEL ** -0.5),
        "w_down": nrm(ks[19], (DEPTH, D_FF, D_MODEL), D_FF ** -0.5),
    }


def reference(x_prompt, x_sample, cache_k, cache_v, state_hgrn, page_table, c_prompt, c_sample,
              w_ada, b_ada, norm1_g, norm2_g, w_in, q_norm_g, k_norm_g, sb_bias, hg_lb_logits, hg_out_g,
              w_out, w_up, w_down):
    lb_sched = jnp.cumsum(jax.nn.softmax(hg_lb_logits.astype(F32), axis=0), axis=0)
    db = x_sample.shape[0]
    s0_prompt = jnp.zeros((x_prompt.shape[0], N_HEADS_HG, HG_KEY_DIM, HG_VAL_DIM), F32)
    y_p, y_s = x_prompt, x_sample
    kp, vp, ks_, vs_, sp, ss = [], [], [], [], [], []
    for l in range(DEPTH):
        lw = (w_ada[l], b_ada[l], norm1_g[l], norm2_g[l], w_in[l], q_norm_g[l], k_norm_g[l],
              sb_bias[l], lb_sched[l], hg_out_g[l], w_out[l], w_up[l], w_down[l])
        y_p, k_new, v_new, s_new = decoder_layer(y_p, c_prompt, *lw, None, None, s0_prompt)
        kp.append(k_new); vp.append(v_new); sp.append(s_new)
        k_past = cache_k[l][page_table].reshape(db, -1, N_HEADS_SB, HEAD_DIM)
        v_past = cache_v[l][page_table].reshape(db, -1, N_HEADS_SB, HEAD_DIM)
        y_s, k_new, v_new, s_new = decoder_layer(y_s, c_sample, *lw, k_past, v_past, state_hgrn[l])
        ks_.append(k_new); vs_.append(v_new); ss.append(s_new)
    return (y_p, y_s, jnp.stack(kp), jnp.stack(vp), jnp.stack(ks_), jnp.stack(vs_), jnp.stack(sp), jnp.stack(ss))
```

```cpp
#include <hip/hip_runtime.h>
#include <cstdio>
#include <cstdint>
namespace cfg {
constexpr int DM = 1024, NP = 16384, NS = 512, MT = NP + NS, NIN = 3584, DFF = 4096, NADA = 6144, NADAROW = 136;
constexpr int SEQ = 2048, DB = 128, DSQ = 4, PAST = 2048, PAGE = 128, NPAGE = 16;
constexpr float EPS = 1e-6f;
constexpr float LOG2E = 1.4426950408889634f;
constexpr float QSCALE = 0.125f * LOG2E;
constexpr size_t O_Y = 0, O_KP = 17301504, O_VP = 25690112, O_KS = 34078720, O_VS = 34340864, O_SP = 34603008, O_SS = 34865152, O_END = 39059456;
}
namespace pg8 {
#define PG8_LAS __attribute__((address_space(3)))
typedef unsigned short bf16_t;
typedef short bf16x8 __attribute__((ext_vector_type(8)));
typedef float f32x4 __attribute__((ext_vector_type(4)));
typedef unsigned u32x4 __attribute__((ext_vector_type(4)));
constexpr int BM = 256, BK = 64, HALF = 128, HTB = HALF * BK * 2  , STAGE_BYTES = 8 * HTB, NXCD = 8, WGM = 8;

__host__ __device__ __forceinline__ int lds_byte(int r, int c) { const int st = (r >> 4) * 2 + (c >> 5), rr = r & 15, cc = c & 31, ob = rr * 64 + cc * 2; return st * 1024 + (ob ^ (((ob >> 9) & 1) << 5)); }
__host__ __device__ __forceinline__ void stage_rc(int b, int& R, int& C) { const int st = b / 1024, sb = b % 1024, swz = sb ^ (((sb >> 9) & 1) << 5); R = (st >> 1) * 16 + swz / 64; C = (st & 1) * 32 + (swz % 64) / 2; }
__host__ __device__ __forceinline__ int perm32(int rho) { const int n = rho >> 4, i = rho & 15; return 8 * (i >> 2) + 4 * n + (i & 3); }

struct Unit { int pm, pn; };
struct Gemm { const bf16_t* A; const bf16_t* Bt; int M, N, K; };

struct StaticOrder {
    int nM, nN, nwg, G, c;
    __host__ __device__ void init(int M, int N, int G_, int c_) { nM = M / BM; nN = N / BM; nwg = nM * nN; G = G_; c = c_; }
    __host__ __device__ bool next(int i, Unit& u) const {
        const long L = (long)i * G + c; if (L >= nwg) return false;
        int wgid = (int)L; { const int q = nwg / NXCD, r = nwg % NXCD, xcd = wgid % NXCD, off = wgid / NXCD; wgid = (xcd < r ? xcd * (q + 1) : r * (q + 1) + (xcd - r) * q) + off; }
        const int nig = WGM * nN, gid = wgid / nig, fm = gid * WGM, gsz = (nM - fm) < WGM ? (nM - fm) : WGM;
        u.pm = fm + ((wgid % nig) % gsz); u.pn = (wgid % nig) / gsz; return true;
    }
    __device__ __forceinline__ void a_ready(const Unit&) const {}
    __device__ __forceinline__ void done(const Unit&) const {}
};


__device__ __forceinline__ unsigned cvt_pk_bf16(float lo, float hi) { unsigned r; asm volatile("v_cvt_pk_bf16_f32 %0, %1, %2" : "=v"(r) : "v"(lo), "v"(hi)); return r; }
__device__ __forceinline__ float ex2(float x) { return __builtin_amdgcn_exp2f(x); }
__device__ __forceinline__ float rcpf_(float x) { return __builtin_amdgcn_rcpf(x); }
__device__ __forceinline__ float sigm(float x) { return rcpf_(1.0f + ex2(x * -1.4426950408889634f)); }
__device__ __forceinline__ u32x4 pack8(f32x4 a, f32x4 b) { u32x4 w; w.x = cvt_pk_bf16(a[0], a[1]); w.y = cvt_pk_bf16(a[2], a[3]); w.z = cvt_pk_bf16(b[0], b[1]); w.w = cvt_pk_bf16(b[2], b[3]); return w; }

struct EpiInProj {
    static constexpr bool PERM = true, AFTER_DRAIN = false;
    bf16_t *Qb, *Kb, *Vb, *HQ, *HV, *HG; float* LF; float* out; const float *qg, *kg, *lbl;
    __device__ __forceinline__ void operator()(const f32x4 (&acc)[2][2][4][2], const Unit& u, int wr, int wc, int fr, int fq) const {
        const int type = u.pn >> 1, head = (u.pn & 1) * 4 + wc;
        const int row0 = u.pm * BM + wr * 64 + fr;
        const int fcol = head * 64 + 8 * fq;
        const bool prompt = u.pm < cfg::NP / BM;
        if (type <= 1) {
            const float* g = type == 0 ? qg : kg;
            f32x4 gv[2][2];
#pragma unroll
            for (int bj = 0; bj < 2; ++bj)
#pragma unroll
                for (int n = 0; n < 2; ++n) gv[bj][n] = *(const f32x4*)(g + 32 * bj + 8 * fq + 4 * n);
            const float post = type == 0 ? cfg::QSCALE : 1.0f;
            bf16_t* ob = type == 0 ? Qb : Kb;
            float* kof = prompt ? out + cfg::O_KP : out + cfg::O_KS - (size_t)cfg::NP * 512;
#pragma unroll
            for (int ai = 0; ai < 2; ++ai)
#pragma unroll
                for (int m = 0; m < 4; ++m) {
                    float ss = 0.f;
#pragma unroll
                    for (int bj = 0; bj < 2; ++bj)
#pragma unroll
                        for (int n = 0; n < 2; ++n) { const f32x4 x = acc[ai][bj][m][n]; ss += (x[0] * x[0] + x[1] * x[1]) + (x[2] * x[2] + x[3] * x[3]); }
                    ss += __shfl_xor(ss, 16); ss += __shfl_xor(ss, 32);
                    const float rstd = __builtin_amdgcn_rsqf(ss * (1.0f / 64.0f) + cfg::EPS);
                    const size_t row = (size_t)(row0 + ai * HALF + m * 16);
#pragma unroll
                    for (int bj = 0; bj < 2; ++bj) {
                        const f32x4 v0 = acc[ai][bj][m][0] * rstd * gv[bj][0], v1 = acc[ai][bj][m][1] * rstd * gv[bj][1];
                        if (type == 1) { float* kp = kof + row * 512 + fcol + 32 * bj; *(f32x4*)kp = v0; *(f32x4*)(kp + 4) = v1; }
                        *(u32x4*)(ob + row * 512 + fcol + 32 * bj) = pack8(v0 * post, v1 * post);
                    }
                }
        } else if (type == 2) {
            float* vof = prompt ? out + cfg::O_VP : out + cfg::O_VS - (size_t)cfg::NP * 512;
#pragma unroll
            for (int ai = 0; ai < 2; ++ai)
#pragma unroll
                for (int m = 0; m < 4; ++m) { const size_t row = (size_t)(row0 + ai * HALF + m * 16);
#pragma unroll
                    for (int bj = 0; bj < 2; ++bj) { const f32x4 v0 = acc[ai][bj][m][0], v1 = acc[ai][bj][m][1];
                        float* vp = vof + row * 512 + fcol + 32 * bj; *(f32x4*)vp = v0; *(f32x4*)(vp + 4) = v1;
                        *(u32x4*)(Vb + row * 512 + fcol + 32 * bj) = pack8(v0, v1); } }
        } else if (type == 4) {
            f32x4 lb[2][2];
#pragma unroll
            for (int bj = 0; bj < 2; ++bj)
#pragma unroll
                for (int n = 0; n < 2; ++n) { const f32x4 l0 = *(const f32x4*)(lbl + fcol + 32 * bj + 4 * n), l1 = *(const f32x4*)(lbl + 512 + fcol + 32 * bj + 4 * n);
#pragma unroll
                    for (int i = 0; i < 4; ++i) lb[bj][n][i] = sigm(l0[i] - l1[i]); }
#pragma unroll
            for (int ai = 0; ai < 2; ++ai)
#pragma unroll
                for (int m = 0; m < 4; ++m) { const size_t row = (size_t)(row0 + ai * HALF + m * 16);
#pragma unroll
                    for (int bj = 0; bj < 2; ++bj)
#pragma unroll
                        for (int n = 0; n < 2; ++n) { f32x4 o;
#pragma unroll
                            for (int i = 0; i < 4; ++i) { const float l = lb[bj][n][i], f = l + (1.0f - l) * sigm(acc[ai][bj][m][n][i]); o[i] = __builtin_amdgcn_logf(f) * 0.6931471805599453f; }
                            *(f32x4*)(LF + row * 512 + fcol + 32 * bj + 4 * n) = o; } }
        } else {
            bf16_t* ob = type == 3 ? HQ : (type == 5 ? HV : HG);
            const bool act = type != 5;
#pragma unroll
            for (int ai = 0; ai < 2; ++ai)
#pragma unroll
                for (int m = 0; m < 4; ++m) { const size_t row = (size_t)(row0 + ai * HALF + m * 16);
#pragma unroll
                    for (int bj = 0; bj < 2; ++bj) { f32x4 v0 = acc[ai][bj][m][0], v1 = acc[ai][bj][m][1];
                        if (act) {
#pragma unroll
                            for (int i = 0; i < 4; ++i) { v0[i] = v0[i] * sigm(v0[i]); v1[i] = v1[i] * sigm(v1[i]); } }
                        *(u32x4*)(ob + row * 512 + fcol + 32 * bj) = pack8(v0, v1); } }
        }
    }
};
struct EpiResGate {
    static constexpr bool PERM = true, AFTER_DRAIN = false;
    const float *base_p, *base_s; float* out; const float* ada; int goff;
    __device__ __forceinline__ void operator()(const f32x4 (&acc)[2][2][4][2], const Unit& u, int wr, int wc, int fr, int fq) const {
        const int row0 = u.pm * BM + wr * 64 + fr, col0 = u.pn * BM + wc * 32 + 8 * fq;
#pragma unroll
        for (int ai = 0; ai < 2; ++ai)
#pragma unroll
            for (int m = 0; m < 4; ++m) { const int row = row0 + ai * HALF + m * 16;
                const int ar = row < cfg::NP ? (row >> 11) : 8 + ((row - cfg::NP) >> 2);
                const float* bp = row < cfg::NP ? base_p + (size_t)row * 1024 : base_s + (size_t)(row - cfg::NP) * 1024;
                const float* gp = ada + (size_t)ar * cfg::NADA + goff; float* op = out + (size_t)row * 1024;
#pragma unroll
                for (int bj = 0; bj < 2; ++bj)
#pragma unroll
                    for (int n = 0; n < 2; ++n) { const int c = col0 + bj * HALF + 4 * n; const f32x4 x = *(const f32x4*)(bp + c), g = *(const f32x4*)(gp + c);
                        *(f32x4*)(op + c) = x + g * acc[ai][bj][m][n]; } }
    }
};
struct EpiRelu2 {
    static constexpr bool PERM = true, AFTER_DRAIN = false;
    bf16_t* O; int ldc;
    __device__ __forceinline__ void operator()(const f32x4 (&acc)[2][2][4][2], const Unit& u, int wr, int wc, int fr, int fq) const {
        const int row0 = u.pm * BM + wr * 64 + fr, col0 = u.pn * BM + wc * 32 + 8 * fq;
#pragma unroll
        for (int ai = 0; ai < 2; ++ai)
#pragma unroll
            for (int m = 0; m < 4; ++m) { bf16_t* rowp = O + (size_t)(row0 + ai * HALF + m * 16) * ldc + col0;
#pragma unroll
                for (int bj = 0; bj < 2; ++bj) { f32x4 v0 = acc[ai][bj][m][0], v1 = acc[ai][bj][m][1];
#pragma unroll
                    for (int i = 0; i < 4; ++i) { const float a = fmaxf(v0[i], 0.f), b = fmaxf(v1[i], 0.f); v0[i] = a * a; v1[i] = b * b; }
                    *(u32x4*)(rowp + bj * HALF) = pack8(v0, v1); } }
    }
};

template <class Epi, class Sched, bool ALIGN_EPI = false, bool SP2 = false>
__device__ __forceinline__ void gemm_phase(PG8_LAS unsigned char* lds, const Gemm g, const Sched& S, const Epi& E) {
    const int tid = threadIdx.x, wid = __builtin_amdgcn_readfirstlane(tid >> 6), lane = tid & 63, wr = wid >> 2, wc = wid & 3, fr = lane & 15, fq = lane >> 4;
    const int K = g.K, nt = K / BK;
    unsigned voffA[2], voffB[2];
#pragma unroll
    for (int i = 0; i < 2; ++i) { int R, C; stage_rc(tid * 16 + i * 8192, R, C); const int Rb = Epi::PERM ? ((R & ~31) + perm32(R & 31)) : R;
        voffA[i] = (unsigned)(R * K + C) * 2u; voffB[i] = (unsigned)(Rb * K + C) * 2u; }
    const size_t kstep = (size_t)(BK * 2);
    const size_t hstep = (size_t)HALF * K * 2;
    const size_t tstep = 2 * hstep;
    const unsigned ldsw = (unsigned)wid * 1024u;
    const int aoff = lds_byte(wr * 64 + fr, fq * 8), boff = lds_byte(wc * 32 + fr, fq * 8);
#define PG8_SA(b, h) (((b) * 2 + (h)) * HTB)
#define PG8_SB(b, h) ((4 + (b) * 2 + (h)) * HTB)
#define PG8_STAGE(bufoff, gbase, voff) do { _Pragma("unroll") for (int _i = 0; _i < 2; ++_i) \
        __builtin_amdgcn_global_load_lds((const unsigned*)((const char*)(gbase) + (voff)[_i]), (PG8_LAS unsigned*)(lds + (bufoff) + ldsw + _i * 8192), 16, 0, 0); } while (0)
#define PG8_LDA(dst, b, h) do { _Pragma("unroll") for (int m = 0; m < 4; ++m) _Pragma("unroll") for (int k = 0; k < 2; ++k) dst[m][k] = *(const PG8_LAS bf16x8*)(lds + PG8_SA(b, h) + aoff + m * 2048 + k * 1024); } while (0)
#define PG8_LDB(dst, b, h) do { _Pragma("unroll") for (int n = 0; n < 2; ++n) _Pragma("unroll") for (int k = 0; k < 2; ++k) dst[n][k] = *(const PG8_LAS bf16x8*)(lds + PG8_SB(b, h) + boff + n * 2048 + k * 1024); } while (0)
#define PG8_MMA(ai, bj, At, Bt) do { __builtin_amdgcn_s_setprio(1); _Pragma("unroll") for (int m = 0; m < 4; ++m) _Pragma("unroll") for (int n = 0; n < 2; ++n) _Pragma("unroll") for (int k = 0; k < 2; ++k) \
        acc[ai][bj][m][n] = __builtin_amdgcn_mfma_f32_16x16x32_bf16(Bt[n][k], At[m][k], acc[ai][bj][m][n], 0, 0, 0); __builtin_amdgcn_s_setprio(0); } while (0)
#define PG8_WAIT_V(n) asm volatile("s_waitcnt vmcnt(" #n ")" ::: "memory")
#define PG8_WAIT_L(n) asm volatile("s_waitcnt lgkmcnt(" #n ")" ::: "memory")
#define PG8_BAR __builtin_amdgcn_s_barrier()
#define PG8_SCHED __builtin_amdgcn_sched_barrier(0)
    Unit cur, nxt; int ui = 0;
    if (!S.next(0, cur)) return;
    f32x4 acc[2][2][4][2];
#pragma unroll
    for (int a = 0; a < 2; ++a)
#pragma unroll
        for (int b = 0; b < 2; ++b)
#pragma unroll
            for (int m = 0; m < 4; ++m)
#pragma unroll
                for (int n = 0; n < 2; ++n) acc[a][b][m][n] = (f32x4){0.f, 0.f, 0.f, 0.f};
    bf16x8 At[4][2], B0[2][2], B1[2][2];
    const char* cA = (const char*)g.A + (size_t)cur.pm * tstep; const char* cB = (const char*)g.Bt + (size_t)cur.pn * tstep;
    S.a_ready(cur);
    if constexpr (SP2) {
        PG8_STAGE(PG8_SB(0, 0), cB, voffB); PG8_STAGE(PG8_SB(0, 1), cB + hstep, voffB); PG8_STAGE(PG8_SA(0, 0), cA, voffA); PG8_STAGE(PG8_SA(0, 1), cA + hstep, voffA);
        if (wr == 1) PG8_BAR;
        PG8_WAIT_V(2); PG8_BAR;
        PG8_STAGE(PG8_SB(1, 0), cB + kstep, voffB); PG8_STAGE(PG8_SA(1, 0), cA + kstep, voffA); PG8_STAGE(PG8_SB(1, 1), cB + hstep + kstep, voffB);
        PG8_WAIT_V(6); PG8_BAR;
    } else {
        PG8_STAGE(PG8_SB(0, 0), cB, voffB); PG8_STAGE(PG8_SA(0, 0), cA, voffA); PG8_STAGE(PG8_SB(0, 1), cB + hstep, voffB); PG8_STAGE(PG8_SA(0, 1), cA + hstep, voffA);
        if (wr == 1) PG8_BAR;
        PG8_WAIT_V(4); PG8_BAR;
        PG8_STAGE(PG8_SB(1, 0), cB + kstep, voffB); PG8_STAGE(PG8_SA(1, 0), cA + kstep, voffA); PG8_STAGE(PG8_SB(1, 1), cB + hstep + kstep, voffB);
        PG8_WAIT_V(6); PG8_BAR;
    }
    for (;;) {
        const bool has_next = S.next(ui + 1, nxt);
        const char* nA = has_next ? (const char*)g.A + (size_t)nxt.pm * tstep : cA; const char* nB = has_next ? (const char*)g.Bt + (size_t)nxt.pn * tstep : cB;
        for (int t = 0; t < nt; t += 2) {
            const bool last = (t == nt - 2);
            const char* a1 = cA + (size_t)(t + 1) * kstep;
            const char* a2 = last ? nA : cA + (size_t)(t + 2) * kstep; const char* b2 = last ? nB : cB + (size_t)(t + 2) * kstep;
            const char* a3 = a2 + kstep; const char* b3 = b2 + kstep;
            if (last && has_next) S.a_ready(nxt);
            if constexpr (SP2) {
            PG8_LDB(B0, 0, 0); PG8_LDB(B1, 0, 1); PG8_SCHED; PG8_LDA(At, 0, 0); PG8_STAGE(PG8_SA(1, 1), a1 + hstep, voffA);
            PG8_WAIT_V(8); PG8_WAIT_L(0); PG8_BAR; PG8_MMA(0, 0, At, B0); PG8_MMA(0, 1, At, B1); PG8_BAR; PG8_SCHED;
            PG8_LDA(At, 0, 1); PG8_STAGE(PG8_SB(0, 0), b2, voffB); PG8_STAGE(PG8_SB(0, 1), b2 + hstep, voffB); PG8_STAGE(PG8_SA(0, 0), a2, voffA);
            PG8_WAIT_V(8); PG8_WAIT_L(0); PG8_BAR; PG8_MMA(1, 0, At, B0); PG8_MMA(1, 1, At, B1); PG8_BAR; PG8_SCHED;
            PG8_LDB(B0, 1, 0); PG8_LDB(B1, 1, 1); PG8_SCHED; PG8_LDA(At, 1, 0); PG8_STAGE(PG8_SA(0, 1), a2 + hstep, voffA);
            PG8_WAIT_V(8); PG8_WAIT_L(0); PG8_BAR; PG8_MMA(0, 0, At, B0); PG8_MMA(0, 1, At, B1); PG8_BAR; PG8_SCHED;
            PG8_LDA(At, 1, 1); PG8_STAGE(PG8_SB(1, 0), b3, voffB); PG8_STAGE(PG8_SB(1, 1), b3 + hstep, voffB); PG8_STAGE(PG8_SA(1, 0), a3, voffA);
            PG8_WAIT_V(8); PG8_WAIT_L(0); PG8_BAR; PG8_MMA(1, 0, At, B0); PG8_MMA(1, 1, At, B1); PG8_BAR; PG8_SCHED;
            } else {
            PG8_LDB(B0, 0, 0); PG8_SCHED; PG8_LDA(At, 0, 0); PG8_STAGE(PG8_SA(1, 1), a1 + hstep, voffA);
            PG8_WAIT_L(8); PG8_BAR; PG8_WAIT_L(0); PG8_MMA(0, 0, At, B0); PG8_BAR; PG8_SCHED;
            PG8_LDB(B1, 0, 1); PG8_STAGE(PG8_SB(0, 0), b2, voffB);
            PG8_BAR; PG8_WAIT_L(0); PG8_MMA(0, 1, At, B1); PG8_BAR;
            PG8_LDA(At, 0, 1); PG8_STAGE(PG8_SA(0, 0), a2, voffA);
            PG8_BAR; PG8_WAIT_L(0); PG8_MMA(1, 0, At, B0); PG8_BAR; PG8_SCHED;
            PG8_STAGE(PG8_SB(0, 1), b2 + hstep, voffB);
            PG8_WAIT_V(6); PG8_BAR; PG8_MMA(1, 1, At, B1); PG8_BAR;
            PG8_LDB(B0, 1, 0); PG8_SCHED; PG8_LDA(At, 1, 0); PG8_STAGE(PG8_SA(0, 1), a2 + hstep, voffA);
            PG8_WAIT_L(8); PG8_BAR; PG8_WAIT_L(0); PG8_MMA(0, 0, At, B0); PG8_BAR; PG8_SCHED;
            PG8_LDB(B1, 1, 1); PG8_STAGE(PG8_SB(1, 0), b3, voffB);
            PG8_BAR; PG8_WAIT_L(0); PG8_MMA(0, 1, At, B1); PG8_BAR;
            PG8_LDA(At, 1, 1); PG8_STAGE(PG8_SA(1, 0), a3, voffA);
            PG8_BAR; PG8_WAIT_L(0); PG8_MMA(1, 0, At, B0); PG8_BAR; PG8_SCHED;
            PG8_STAGE(PG8_SB(1, 1), b3 + hstep, voffB);
            PG8_WAIT_V(6); PG8_BAR; PG8_MMA(1, 1, At, B1); PG8_BAR;
            }
        }
        if constexpr (ALIGN_EPI) { if (wr == 0) PG8_BAR; }
        if constexpr (!Epi::AFTER_DRAIN) { E(acc, cur, wr, wc, fr, fq); S.done(cur); }
        if (!has_next) break;
#pragma unroll
        for (int a = 0; a < 2; ++a)
#pragma unroll
            for (int b = 0; b < 2; ++b)
#pragma unroll
                for (int m = 0; m < 4; ++m)
#pragma unroll
                    for (int n = 0; n < 2; ++n) acc[a][b][m][n] = (f32x4){0.f, 0.f, 0.f, 0.f};
        cur = nxt; cA = nA; cB = nB; ++ui;
        if constexpr (ALIGN_EPI) { if (wr == 1) PG8_BAR; }
    }
    PG8_WAIT_V(0);
    if constexpr (!ALIGN_EPI) { if (wr == 0) PG8_BAR; }
    PG8_BAR;
    if constexpr (Epi::AFTER_DRAIN) { E.fused(acc, cur, wr, wc, fr, fq, lds, wid, lane); S.done(cur); }
#undef PG8_SA
#undef PG8_SB
#undef PG8_STAGE
#undef PG8_LDA
#undef PG8_LDB
#undef PG8_MMA
#undef PG8_WAIT_V
#undef PG8_WAIT_L
#undef PG8_BAR
#undef PG8_SCHED
}
}

constexpr int NWAVES = 8;
#ifndef MK_N_LAUNCHES
#define MK_N_LAUNCHES 1
#endif
constexpr int N_LAUNCHES = MK_N_LAUNCHES;
constexpr int NPHASE = 9;
using namespace cfg;

constexpr size_t MiB = 1u << 20;
constexpr size_t WS_CTL = 0, CTL_ZERO_BYTES = 1 * MiB;
constexpr size_t WS_WIN = 2 * MiB, WS_WOUT = 9 * MiB, WS_WUP = 11 * MiB, WS_WDN = 19 * MiB;
constexpr size_t WS_ADA = 27 * MiB;
constexpr size_t WS_DPO = 31 * MiB, WS_DPP = 34 * MiB;
constexpr size_t WS_H = 36 * MiB;
constexpr size_t WS_Q = 70 * MiB, WS_K = 87 * MiB, WS_V = 104 * MiB, WS_HQ = 121 * MiB, WS_HV = 138 * MiB, WS_HG = 155 * MiB;
constexpr size_t WS_LF = 172 * MiB;
constexpr size_t WS_MIX = 205 * MiB;
constexpr size_t WS_HUP = 240 * MiB, WS_END = 372 * MiB;
constexpr int CW_BAR = 4096;

constexpr int RING_OFF = 0, RING_BYTES = 131072;
constexpr int LDSCTL_OFF = RING_BYTES, MISC_OFF = LDSCTL_OFF + 320;
constexpr int LDS_BYTES = 147456;

#define GAS __attribute__((address_space(1)))
#define LAS __attribute__((address_space(3)))
typedef unsigned short bf16;
typedef unsigned v4u __attribute__((ext_vector_type(4)));
typedef unsigned v2u __attribute__((ext_vector_type(2)));
typedef float f32x4 __attribute__((ext_vector_type(4)));
typedef float f32x16 __attribute__((ext_vector_type(16)));
typedef short bf16x8 __attribute__((ext_vector_type(8)));
typedef short s16x4 __attribute__((ext_vector_type(4)));
typedef GAS unsigned gu32;
#define RLX_AGENT __ATOMIC_RELAXED, __HIP_MEMORY_SCOPE_AGENT
#define LDS_WAIT() asm volatile("s_waitcnt lgkmcnt(0)" ::: "memory")
#define VM_WAIT() asm volatile("s_waitcnt vmcnt(0)" ::: "memory")
__device__ __forceinline__ unsigned f2bf(float f) { unsigned u = __builtin_bit_cast(unsigned, f); return (u + 0x7fffu + ((u >> 16) & 1u)) >> 16; }
__device__ __forceinline__ unsigned pk2(float lo, float hi) { return pg8::cvt_pk_bf16(lo, hi); }
__device__ __forceinline__ float bf2f(unsigned short b) { return __builtin_bit_cast(float, (unsigned)b << 16); }
__device__ __forceinline__ float bflo(unsigned w) { return __builtin_bit_cast(float, w << 16); }
__device__ __forceinline__ float bfhi(unsigned w) { return __builtin_bit_cast(float, w & 0xffff0000u); }
using pg8::ex2; using pg8::rcpf_; using pg8::sigm;
__device__ __forceinline__ float wave_sum(float v) {
#pragma unroll
    for (int o = 1; o < 64; o <<= 1) v += __shfl_xor(v, o);
    return v;
}
__device__ __forceinline__ s16x4 vtr(const LAS unsigned char* p) { return __builtin_bit_cast(s16x4, __builtin_amdgcn_ds_read_tr16_b64_v4i16((LAS s16x4*)p)); }
__device__ __forceinline__ bf16x8 cat8(s16x4 a, s16x4 b) { return (bf16x8){a[0], a[1], a[2], a[3], b[0], b[1], b[2], b[3]}; }

#define XB_TMO      128
#define XB_XCNT(j)  (256  + 64 * (j))
#define XB_XSUB(j)  (1280 + 64 * (j))
#define XB_XGEN(j)  (2304 + 64 * (j))
#define XB_TOP      3328
#define XB_TOPGEN   3392
#define XCD_BAR_WORDS 3456
#define XB_SPIN_CAP (1u << 18)

__device__ __forceinline__ unsigned xb_ld(unsigned* p)              { return __hip_atomic_load(p, __ATOMIC_RELAXED, __HIP_MEMORY_SCOPE_AGENT); }
__device__ __forceinline__ unsigned xb_add(unsigned* p, unsigned v) { return __hip_atomic_fetch_add(p, v, __ATOMIC_RELAXED, __HIP_MEMORY_SCOPE_AGENT); }
__device__ __forceinline__ unsigned xb_xcc_id() { return (unsigned)__builtin_amdgcn_s_getreg((3 << 11) | 20) & 0xFu; }
#define XB_SPIN(cond, bar) do { unsigned _sp = 0; while (cond) { __builtin_amdgcn_s_sleep(1); \
    if ((++_sp & 255u) == 0u) { if (xb_ld(&(bar)[XB_TMO])) break; if (_sp > XB_SPIN_CAP) { atomicAdd(&(bar)[XB_TMO], 1u); break; } } } } while (0)

struct XcdBarrier {
    unsigned* bar; unsigned x;
    volatile LAS unsigned* st;
};

__device__ __forceinline__ XcdBarrier xcd_barrier_post(unsigned* bar, volatile LAS unsigned* st) {
    XcdBarrier b; b.bar = bar; b.x = xb_xcc_id(); b.st = st;
    if (threadIdx.x == 0) (void)xb_add(&bar[XB_XCNT(b.x)], 1u);
    return b;
}
__device__ __forceinline__ void xcd_barrier_complete(unsigned* bar, unsigned x, unsigned& nloc, unsigned& nx) {
    const unsigned G = gridDim.x * gridDim.y * gridDim.z;
    unsigned sum, cnt, mine, sp = 0u;
    for (;;) {
        sum = 0u; cnt = 0u; mine = 0u;
#pragma unroll
        for (unsigned j = 0; j < 16; ++j) { const unsigned c = xb_ld(&bar[XB_XCNT(j)]); sum += c; cnt += (c > 0u) ? 1u : 0u; mine = (j == x) ? c : mine; }
        if (sum == G) break;
        __builtin_amdgcn_s_sleep(1);
        if ((++sp & 255u) == 0u) { if (xb_ld(&bar[XB_TMO])) break; if (sp > XB_SPIN_CAP) { atomicAdd(&bar[XB_TMO], 1u); break; } }
    }
    nloc = mine > 0u ? mine : 1u; nx = cnt > 0u ? cnt : 1u;
}

__device__ __forceinline__ void xcd_barrier(const XcdBarrier& b) {
    asm volatile("s_waitcnt vmcnt(0)" ::: "memory");
    __syncthreads();
    if (threadIdx.x == 0) {
        unsigned* bar = b.bar;
        __builtin_amdgcn_s_waitcnt(0);
        unsigned nloc = b.st[0], nx = b.st[1];
        if (nloc == 0u) { xcd_barrier_complete(bar, b.x, nloc, nx); b.st[0] = nloc; b.st[1] = nx; }
        const unsigned old = xb_add(&bar[XB_XSUB(b.x)], 1u);
        const unsigned gen = old / nloc;
        if (old + 1u == (gen + 1u) * nloc) {
            __builtin_amdgcn_fence(__ATOMIC_RELEASE, "agent");
            asm volatile("s_waitcnt vmcnt(0)" ::: "memory");
            const unsigned og = xb_add(&bar[XB_TOP], 1u);
            const unsigned tg = og / nx;
            if (og + 1u == (tg + 1u) * nx) xb_add(&bar[XB_TOPGEN], 1u);
            else XB_SPIN(xb_ld(&bar[XB_TOPGEN]) == tg, bar);
            __builtin_amdgcn_fence(__ATOMIC_ACQUIRE, "agent");
            xb_add(&bar[XB_XGEN(b.x)], 1u);
            asm volatile("s_waitcnt vmcnt(0)" ::: "memory");
        } else {
            XB_SPIN(xb_ld(&bar[XB_XGEN(b.x)]) == gen, bar);
            __builtin_amdgcn_fence(__ATOMIC_ACQUIRE, "agent");
            asm volatile("s_waitcnt vmcnt(0)" ::: "memory");
        }
    }
    __syncthreads();
}

struct Args { const float* in[21]; float* out; unsigned char* ws; int ph_lo, ph_hi; };

__device__ __forceinline__ void p0_transpose_item(const float* W, int K, int N, bf16* WT, bool headperm, LAS float* scr, int item, int lane) {
    const int nblk = N / 32, kb = item / nblk, nb = item % nblk, k0 = 64 * kb, n0 = 32 * nb;
#pragma unroll 8
    for (int i = 0; i < 32; ++i) { const int kk = 2 * i + (lane >> 5); scr[kk * 33 + (lane & 31)] = W[(size_t)(k0 + kk) * N + n0 + (lane & 31)]; }
    LDS_WAIT(); asm volatile("" ::: "memory");
    int drow0 = n0;
    if (headperm) { const int g = (n0 & 255) >> 5; drow0 = (n0 & ~255) + 32 * (4 * (g & 1) + (g >> 1)); }
    const int c = lane & 7;
#pragma unroll
    for (int j = 0; j < 4; ++j) { const int n = (lane >> 3) + 8 * j; const LAS float* s = scr + (8 * c) * 33 + n;
        v4u o; o.x = pk2(s[0 * 33], s[1 * 33]); o.y = pk2(s[2 * 33], s[3 * 33]); o.z = pk2(s[4 * 33], s[5 * 33]); o.w = pk2(s[6 * 33], s[7 * 33]);
        *(GAS v4u*)(WT + (size_t)(drow0 + n) * K + k0 + 8 * c) = o; }
    LDS_WAIT(); asm volatile("" ::: "memory");
}
__device__ __forceinline__ float siluf(float x) { return x * sigm(x); }
__device__ __forceinline__ void p0_prologue(const Args& a, LAS unsigned char* lds, int tid, int lane, int wave, int bid, int G) {
    unsigned char* ws = a.ws;
    {
        LAS float* scr = (LAS float*)(lds + RING_OFF + wave * 16384);
        const int gw = bid * NWAVES + wave, NGW = G * NWAVES;
        constexpr int I_IN = (DM / 64) * (NIN / 32), I_OUT = (DM / 64) * (DM / 32), I_UP = (DM / 64) * (DFF / 32), I_DN = (DFF / 64) * (DM / 32);
        constexpr int NITEMS = I_IN + I_OUT + I_UP + I_DN;
        for (int it = gw; it < NITEMS; it += NGW) {
            int r = it;
            if (r < I_IN) { p0_transpose_item(a.in[12], DM, NIN, (bf16*)(ws + WS_WIN), true, scr, r, lane); continue; } r -= I_IN;
            if (r < I_OUT) { p0_transpose_item(a.in[18], DM, DM, (bf16*)(ws + WS_WOUT), false, scr, r, lane); continue; } r -= I_OUT;
            if (r < I_UP) { p0_transpose_item(a.in[19], DM, DFF, (bf16*)(ws + WS_WUP), false, scr, r, lane); continue; } r -= I_UP;
            p0_transpose_item(a.in[20], DFF, DM, (bf16*)(ws + WS_WDN), false, scr, r, lane);
        }
    }
    __syncthreads();
    {
        const float* w_ada = a.in[8]; const float* b_ada = a.in[9]; const float* c_p = a.in[6]; const float* c_s = a.in[7];
        float* ADA = (float*)(ws + WS_ADA);
        LAS bf16* Wt = (LAS bf16*)(lds + RING_OFF);
        constexpr int WST = 1032;
        for (int cb = bid; cb < NADA / 24; cb += G) {
            const int n0 = 24 * cb;
            for (int idx = tid; idx < 1024 * 6; idx += NWAVES * 64) { const int k = idx / 6, c4 = idx % 6;
                const f32x4 v = *(const f32x4*)(w_ada + (size_t)k * NADA + n0 + 4 * c4);
#pragma unroll
                for (int i = 0; i < 4; ++i) Wt[(4 * c4 + i) * WST + k] = (bf16)f2bf(v[i]); }
            for (int idx = tid; idx < 8 * 1024; idx += NWAVES * 64) Wt[(24 + (idx >> 10)) * WST + (idx & 1023)] = 0;
            __syncthreads();
            for (int rt = wave; rt < 9; rt += NWAVES) {
                const int row = 16 * rt + (lane & 15), rowc = row < NADAROW ? row : NADAROW - 1;
                const float* crow = rowc < 8 ? c_p + (size_t)rowc * DM : c_s + (size_t)(rowc - 8) * DM;
                f32x4 acc0 = {0.f, 0.f, 0.f, 0.f}, acc1 = {0.f, 0.f, 0.f, 0.f};
#pragma unroll 4
                for (int ks = 0; ks < 32; ++ks) {
                    const int k = 32 * ks + 8 * (lane >> 4);
                    const f32x4 a0 = *(const f32x4*)(crow + k), a1 = *(const f32x4*)(crow + k + 4);
                    v4u aw; aw.x = pk2(siluf(a0[0]), siluf(a0[1])); aw.y = pk2(siluf(a0[2]), siluf(a0[3])); aw.z = pk2(siluf(a1[0]), siluf(a1[1])); aw.w = pk2(siluf(a1[2]), siluf(a1[3]));
                    const bf16x8 A = __builtin_bit_cast(bf16x8, aw);
                    const bf16x8 B0 = *(const LAS bf16x8*)(Wt + (lane & 15) * WST + k), B1 = *(const LAS bf16x8*)(Wt + (16 + (lane & 15)) * WST + k);
                    acc0 = __builtin_amdgcn_mfma_f32_16x16x32_bf16(A, B0, acc0, 0, 0, 0);
                    acc1 = __builtin_amdgcn_mfma_f32_16x16x32_bf16(A, B1, acc1, 0, 0, 0);
                }
                const int n = lane & 15;
#pragma unroll
                for (int i = 0; i < 4; ++i) { const int r = 16 * rt + 4 * (lane >> 4) + i;
                    if (r < NADAROW) { ADA[(size_t)r * NADA + n0 + n] = acc0[i] + b_ada[n0 + n]; if (n < 8) ADA[(size_t)r * NADA + n0 + 16 + n] = acc1[i] + b_ada[n0 + 16 + n]; } }
            }
            __syncthreads();
        }
    }
}

__device__ __forceinline__ void norm_mod_phase(const float* src_p, const float* src_s, const float* ADA, int sh_off, int sc_off, const float* gain, bf16* H, int lane, int wave, int bid, int G) {
    const int gw = bid * NWAVES + wave, NGW = G * NWAVES;
    for (int m = gw; m < MT; m += NGW) {
        const float* xr; int ar;
        if (m < NP) { xr = src_p + (size_t)m * DM; ar = m >> 11; } else { xr = src_s + (size_t)(m - NP) * DM; ar = 8 + ((m - NP) >> 2); }
        const f32x4* x4 = (const f32x4*)xr + lane;
        f32x4 v[4]; float s = 0.f;
#pragma unroll
        for (int j = 0; j < 4; ++j) { v[j] = x4[64 * j]; s += (v[j].x * v[j].x + v[j].y * v[j].y) + (v[j].z * v[j].z + v[j].w * v[j].w); }
        const float rstd = __builtin_amdgcn_rsqf(wave_sum(s) * (1.f / DM) + EPS);
        const float* ap = ADA + (size_t)ar * NADA;
        unsigned long long* o8 = (unsigned long long*)(H + (size_t)m * DM) + lane;
#pragma unroll
        for (int j = 0; j < 4; ++j) { const int c = 4 * (lane + 64 * j);
            const f32x4 g = *(const f32x4*)(gain + c), sc = *(const f32x4*)(ap + sc_off + c), sh = *(const f32x4*)(ap + sh_off + c);
            const f32x4 y = v[j] * rstd * g * (1.0f + sc) + sh;
            o8[64 * j] = (unsigned long long)pk2(y.x, y.y) | ((unsigned long long)pk2(y.z, y.w) << 32); }
    }
}

constexpr int AT_KS = 144, AT_VS = 192;
constexpr int AT_K = 0, AT_V = 2 * 64 * AT_KS, AT_BYTES = AT_V + 2 * 64 * AT_VS;
__device__ __forceinline__ void attn_unit(const bf16* __restrict__ Qb, const bf16* __restrict__ Kb, const bf16* __restrict__ Vb, bf16* MIX, const float* sb_bias,
                                          LAS unsigned char* lds, int tid, int lane, int wave, int b, int h, int qb) {
    const int r32 = lane & 31, hi = lane >> 5, trel = 32 * wave + r32;
    const size_t mq = (size_t)b * SEQ + 256 * qb + trel;
    bf16x8 qr[4];
#pragma unroll
    for (int ds = 0; ds < 4; ++ds) qr[ds] = *(const bf16x8*)(Qb + mq * 512 + 64 * h + 16 * ds + 8 * hi);
    const float bias2 = sb_bias[h] * LOG2E;
    f32x16 o0, o1;
#pragma unroll
    for (int i = 0; i < 16; ++i) { o0[i] = 0.f; o1[i] = 0.f; }
    float R = 1.0f;
    const int NT = 4 * (qb + 1);
    const int skey = tid >> 3, sch = tid & 7;
    const bf16* kg = Kb + ((size_t)b * SEQ + skey) * 512 + 64 * h + 8 * sch;
    const bf16* vg = Vb + ((size_t)b * SEQ + skey) * 512 + 64 * h + 8 * sch;
    v4u kreg = *(const v4u*)(kg + (size_t)(NT - 1) * 64 * 512), vreg = *(const v4u*)(vg + (size_t)(NT - 1) * 64 * 512);
    const int kwr = skey * AT_KS + sch * 16, vwr = skey * AT_VS + sch * 16;
    const int krd = (32 * ((r32 >> 2) & 1) + (r32 & 3) + 4 * (r32 >> 3)) * AT_KS + 16 * hi;
    const int g16 = lane >> 4;
    const int vrd = (32 * (g16 >> 1) + ((lane & 15) >> 2)) * AT_VS + (16 * (g16 & 1) + 4 * (lane & 3)) * 2;
    int buf = 0;
    for (int jt = NT - 1; jt >= 0; --jt, buf ^= 1) {
        *(LAS v4u*)(lds + AT_K + buf * 64 * AT_KS + kwr) = kreg;
        *(LAS v4u*)(lds + AT_V + buf * 64 * AT_VS + vwr) = vreg;
        __syncthreads();
        if (jt > 0) { kreg = *(const v4u*)(kg + (size_t)(jt - 1) * 64 * 512); vreg = *(const v4u*)(vg + (size_t)(jt - 1) * 64 * 512); }
        const int jrel = jt - (NT - 4);
        if (jrel >= 0 && 2 * jrel > wave) continue;
        const LAS unsigned char* Kt = lds + AT_K + buf * 64 * AT_KS + krd;
        const LAS unsigned char* Vt = lds + AT_V + buf * 64 * AT_VS + vrd;
        f32x16 p0, p1;
#pragma unroll
        for (int i = 0; i < 16; ++i) { p0[i] = bias2; p1[i] = bias2; }
#pragma unroll
        for (int ds = 0; ds < 4; ++ds) {
            const bf16x8 a0 = *(const LAS bf16x8*)(Kt + 32 * ds), a1 = *(const LAS bf16x8*)(Kt + 16 * AT_KS + 32 * ds);
            p0 = __builtin_amdgcn_mfma_f32_32x32x16_bf16(a0, qr[ds], p0, 0, 0, 0);
            p1 = __builtin_amdgcn_mfma_f32_32x32x16_bf16(a1, qr[ds], p1, 0, 0, 0);
        }
        float e[32], r[32];
#pragma unroll
        for (int i = 0; i < 16; ++i) { e[i] = ex2(fminf(p0[i], 126.0f)); e[16 + i] = ex2(fminf(p1[i], 126.0f)); }
        if (jrel >= 0) {
            const int sb0 = 64 * jrel + 32 * hi;
#pragma unroll
            for (int i = 0; i < 32; ++i) e[i] = (sb0 + i < trel) ? e[i] : 0.0f;
        }
#pragma unroll
        for (int i = 0; i < 32; ++i) r[i] = rcpf_(1.0f + e[i]);
        float T;
        { float t8[8];
#pragma unroll
          for (int i = 0; i < 8; ++i) t8[i] = (r[4 * i] * r[4 * i + 1]) * (r[4 * i + 2] * r[4 * i + 3]);
          T = ((t8[0] * t8[1]) * (t8[2] * t8[3])) * ((t8[4] * t8[5]) * (t8[6] * t8[7])); }
        const float Tp = __shfl_xor(T, 32);
        float c = hi ? R : R * Tp;
#pragma unroll
        for (int i = 31; i >= 0; --i) { c *= r[i]; e[i] *= c; }
        R = R * T * Tp;
        bf16x8 pw[4];
#pragma unroll
        for (int j = 0; j < 4; ++j) { v4u w; w.x = pk2(e[8 * j], e[8 * j + 1]); w.y = pk2(e[8 * j + 2], e[8 * j + 3]); w.z = pk2(e[8 * j + 4], e[8 * j + 5]); w.w = pk2(e[8 * j + 6], e[8 * j + 7]); pw[j] = __builtin_bit_cast(bf16x8, w); }
#pragma unroll
        for (int j = 0; j < 4; ++j) {
            const bf16x8 v0 = cat8(vtr(Vt + j * 8 * AT_VS), vtr(Vt + j * 8 * AT_VS + 4 * AT_VS));
            const bf16x8 v1 = cat8(vtr(Vt + j * 8 * AT_VS + 64), vtr(Vt + j * 8 * AT_VS + 4 * AT_VS + 64));
            o0 = __builtin_amdgcn_mfma_f32_32x32x16_bf16(v0, pw[j], o0, 0, 0, 0);
            o1 = __builtin_amdgcn_mfma_f32_32x32x16_bf16(v1, pw[j], o1, 0, 0, 0);
        }
    }
    bf16* op = MIX + mq * DM + 64 * h + 4 * hi;
#pragma unroll
    for (int g4 = 0; g4 < 4; ++g4) {
        v2u w0, w1; w0.x = pk2(o0[4 * g4], o0[4 * g4 + 1]); w0.y = pk2(o0[4 * g4 + 2], o0[4 * g4 + 3]); w1.x = pk2(o1[4 * g4], o1[4 * g4 + 1]); w1.y = pk2(o1[4 * g4 + 2], o1[4 * g4 + 3]);
        *(v2u*)(op + 8 * g4) = w0; *(v2u*)(op + 32 + 8 * g4) = w1; }
    __syncthreads();
}

__device__ __forceinline__ void dec_step(const f32x4 (&kv)[4], const f32x4 (&vv)[4], const f32x4 (&qv)[4], float bias2, bool newkeys, int lane, float& R, f32x4 (&o)[4]) {
    float v[16];
#pragma unroll
    for (int i = 0; i < 4; ++i)
#pragma unroll
        for (int t = 0; t < 4; ++t) v[4 * i + t] = (kv[i].x * qv[t].x + kv[i].y * qv[t].y) + (kv[i].z * qv[t].z + kv[i].w * qv[t].w);
    float n8[8], n4[4], n2[2];
    const bool b0 = lane & 1, b1 = lane & 2, b2 = lane & 4, b3 = lane & 8;
#pragma unroll
    for (int j = 0; j < 8; ++j) n8[j] = (b0 ? v[2 * j + 1] : v[2 * j]) + __shfl_xor(b0 ? v[2 * j] : v[2 * j + 1], 1);
#pragma unroll
    for (int j = 0; j < 4; ++j) n4[j] = (b1 ? n8[2 * j + 1] : n8[2 * j]) + __shfl_xor(b1 ? n8[2 * j] : n8[2 * j + 1], 2);
#pragma unroll
    for (int j = 0; j < 2; ++j) n2[j] = (b2 ? n4[2 * j + 1] : n4[2 * j]) + __shfl_xor(b2 ? n4[2 * j] : n4[2 * j + 1], 4);
    const float sc = (b3 ? n2[1] : n2[0]) + __shfl_xor(b3 ? n2[0] : n2[1], 8);
    const int kappa = lane >> 2, t = lane & 3;
    float e = ex2(fminf(sc + bias2, 126.0f));
    if (newkeys) e = (kappa < t) ? e : 0.0f;
    const float r = rcpf_(1.0f + e);
    float x = r;
#pragma unroll
    for (int d = 4; d < 64; d <<= 1) { const float y = __shfl_down(x, d); x *= (lane + d < 64) ? y : 1.0f; }
    const float xs = __shfl_down(x, 4);
    const float excl = (lane + 4 < 64) ? xs : 1.0f;
    const float tot = __shfl(x, t);
    const float w = e * r * excl * R;
    R *= tot;
#pragma unroll
    for (int i = 0; i < 4; ++i)
#pragma unroll
        for (int tt = 0; tt < 4; ++tt) { const float wb = __shfl(w, (lane & 48) + 4 * i + tt); o[tt] += wb * vv[i]; }
}
__device__ __forceinline__ void dec_attn_item(const Args& a, int item, int lane, int wave) {
    const int sb = item >> 1, half = item & 1, h = wave, g = lane >> 4, c = lane & 15;
    const bf16* Qb = (const bf16*)(a.ws + WS_Q);
    const float* ck = a.in[2]; const float* cv = a.in[3]; const int* pt = (const int*)a.in[5] + sb * NPAGE;
    const float bias2 = a.in[15][h] * LOG2E;
    f32x4 qv[4];
#pragma unroll
    for (int t = 0; t < 4; ++t) { const v2u w = *(const v2u*)(Qb + (size_t)(NP + 4 * sb + t) * 512 + 64 * h + 4 * c); qv[t] = (f32x4){bflo(w.x), bfhi(w.x), bflo(w.y), bfhi(w.y)}; }
    f32x4 o[4];
#pragma unroll
    for (int t = 0; t < 4; ++t) o[t] = (f32x4){0.f, 0.f, 0.f, 0.f};
    float R = 1.0f;
    const size_t lane_off = (size_t)(4 * g) * 512 + 64 * h + 4 * c;
    if (half == 1) {
        const float* kp = a.out + O_KS + (size_t)(4 * sb) * 512 + 64 * h + 4 * c; const float* vp = a.out + O_VS + (size_t)(4 * sb) * 512 + 64 * h + 4 * c;
        f32x4 kv[4], vv[4];
#pragma unroll
        for (int i = 0; i < 4; ++i) { const int kk = (g == 0) ? i : 0; kv[i] = *(const f32x4*)(kp + kk * 512); vv[i] = *(const f32x4*)(vp + kk * 512); }
        dec_step(kv, vv, qv, bias2, true, lane, R, o);
    }
    const int top = half ? 15 : 7;
    f32x4 ka[4], va[4], kb[4], vb[4];
#define DEC_LOAD(KK, VV, s) do { const int pg_ = top - ((s) >> 3), st_ = 7 - ((s) & 7); const size_t base_ = ((size_t)pt[pg_] * PAGE + 16 * st_) * 512 + lane_off; \
        _Pragma("unroll") for (int i = 0; i < 4; ++i) { KK[i] = __builtin_nontemporal_load((const f32x4*)(ck + base_ + i * 512)); VV[i] = __builtin_nontemporal_load((const f32x4*)(cv + base_ + i * 512)); } } while (0)
    DEC_LOAD(ka, va, 0);
    for (int s = 0; s < 64; s += 2) {
        DEC_LOAD(kb, vb, s + 1);
        dec_step(ka, va, qv, bias2, false, lane, R, o);
        if (s + 2 < 64) DEC_LOAD(ka, va, s + 2);
        dec_step(kb, vb, qv, bias2, false, lane, R, o);
    }
#undef DEC_LOAD
#pragma unroll
    for (int t = 0; t < 4; ++t)
#pragma unroll
        for (int d = 0; d < 4; ++d) { float x = o[t][d]; x += __shfl_xor(x, 16); x += __shfl_xor(x, 32); o[t][d] = x; }
    float* DPO = (float*)(a.ws + WS_DPO) + ((size_t)((sb * 2 + half) * 8 + h) * 4) * 64;
    if (g == 0) {
#pragma unroll
        for (int t = 0; t < 4; ++t) *(f32x4*)(DPO + t * 64 + 4 * c) = o[t]; }
    if (lane < 4) ((float*)(a.ws + WS_DPP))[((sb * 2 + half) * 8 + h) * 4 + lane] = R;
}

__device__ __forceinline__ void dec_hgrn_item(const Args& a, int item, int lane) {
    const int sb = item >> 3, h = item & 7;
    const float* LF = (const float*)(a.ws + WS_LF); const bf16* HQ = (const bf16*)(a.ws + WS_HQ); const bf16* HV = (const bf16*)(a.ws + WS_HV); const bf16* HG = (const bf16*)(a.ws + WS_HG);
    bf16* MIX = (bf16*)(a.ws + WS_MIX);
    const float* s0 = a.in[4] + (size_t)(sb * 8 + h) * 4096;
    float S[64];
#pragma unroll
    for (int k = 0; k < 64; ++k) S[k] = s0[k * 64 + lane];
    const float gain = a.in[17][lane];
#pragma unroll 1
    for (int t = 0; t < 4; ++t) {
        const size_t m = (size_t)NP + 4 * sb + t;
        const float lf = LF[m * 512 + 64 * h + lane];
        const float f = ex2(lf * LOG2E), kk = 1.0f - f, q = bf2f(HQ[m * 512 + 64 * h + lane]), vt = bf2f(HV[m * 512 + 64 * h + lane]), gt = bf2f(HG[m * 512 + 64 * h + lane]);
        float o = 0.f;
#pragma unroll
        for (int k = 0; k < 64; ++k) {
            const float fk = __builtin_bit_cast(float, __builtin_amdgcn_readlane(__builtin_bit_cast(int, f), k));
            const float kv = __builtin_bit_cast(float, __builtin_amdgcn_readlane(__builtin_bit_cast(int, kk), k));
            const float qk = __builtin_bit_cast(float, __builtin_amdgcn_readlane(__builtin_bit_cast(int, q), k));
            S[k] = fk * S[k] + kv * vt; o += S[k] * qk; }
        const float ss = wave_sum(o * o);
        const float y = o * __builtin_amdgcn_rsqf(ss * (1.0f / 64.0f) + EPS) * gain * gt;
        MIX[m * DM + 512 + 64 * h + lane] = (bf16)f2bf(y);
        const float* DPO = (const float*)(a.ws + WS_DPO); const float* DPP = (const float*)(a.ws + WS_DPP);
        const float o1 = DPO[((size_t)((sb * 2 + 1) * 8 + h) * 4 + t) * 64 + lane], o0v = DPO[((size_t)((sb * 2 + 0) * 8 + h) * 4 + t) * 64 + lane], p1 = DPP[((sb * 2 + 1) * 8 + h) * 4 + t];
        MIX[m * DM + 64 * h + lane] = (bf16)f2bf(o1 + p1 * o0v);
    }
    float* so = a.out + O_SS + (size_t)(sb * 8 + h) * 4096;
#pragma unroll
    for (int k = 0; k < 64; ++k) so[k * 64 + lane] = S[k];
}

constexpr int HG_SEG = 0, HG_DEC = 2048, HG_QD = 4096, HG_ROW = 144, HG_KD = HG_QD + 64 * HG_ROW, HG_KET = HG_KD + 64 * HG_ROW, HG_V = HG_KET + 64 * HG_ROW, HG_VS = 192,
              HG_OB = HG_V + 64 * HG_VS, HG_OBS = 272, HG_BYTES = HG_OB + 64 * HG_OBS;
__device__ __forceinline__ void hgrn_chain(const Args& a, LAS unsigned char* lds, int tid, int lane, int wave, int b, int h) {
    const float* LF = (const float*)(a.ws + WS_LF); const bf16* HQ = (const bf16*)(a.ws + WS_HQ); const bf16* HV = (const bf16*)(a.ws + WS_HV); const bf16* HG = (const bf16*)(a.ws + WS_HG);
    bf16* MIX = (bf16*)(a.ws + WS_MIX);
    const int k = lane, seg = wave;
    const int tB = tid >> 3, c8 = tid & 7;
    const int r32 = lane & 31, hi = lane >> 5, tb = (wave >> 1) & 1, vb = wave & 1, g16 = lane >> 4;
    f32x16 S0, S1;
#pragma unroll
    for (int i = 0; i < 16; ++i) { S0[i] = 0.f; S1[i] = 0.f; }
    float lfr[8]; unsigned short qh[8]; v4u vld, gld;
#define HG_LOAD(n) do { const size_t m0_ = (size_t)b * SEQ + 64 * (n); \
        _Pragma("unroll") for (int j = 0; j < 8; ++j) { lfr[j] = LF[(m0_ + 8 * seg + j) * 512 + 64 * h + k]; qh[j] = HQ[(m0_ + 8 * seg + j) * 512 + 64 * h + k]; } \
        vld = *(const v4u*)(HV + (m0_ + tB) * 512 + 64 * h + 8 * c8); gld = *(const v4u*)(HG + (m0_ + tB) * 512 + 64 * h + 8 * c8); } while (0)
    HG_LOAD(0);
    LAS float* SEG = (LAS float*)(lds + HG_SEG); LAS float* DEC = (LAS float*)(lds + HG_DEC);
    const f32x4 gn0 = *(const f32x4*)(a.in[17] + 8 * c8), gn1 = *(const f32x4*)(a.in[17] + 8 * c8 + 4);
    const int krd = (32 * ((r32 >> 2) & 1) + (r32 & 3) + 4 * (r32 >> 3)) * HG_ROW + 16 * hi;
    const int vrd_l = (32 * (g16 >> 1) + ((lane & 15) >> 2)) * HG_VS + (32 * vb + 16 * (g16 & 1) + 4 * (lane & 3)) * 2;
    const int vrd_n = (8 * (g16 >> 1) + ((lane & 15) >> 2)) * HG_VS + (32 * vb + 16 * (g16 & 1) + 4 * (lane & 3)) * 2;
#pragma unroll 1
    for (int n = 0; n < SEQ / 64; ++n) {
        const size_t m0 = (size_t)b * SEQ + 64 * n;
        float cum[8];
        { float s = 0.f;
#pragma unroll
          for (int j = 0; j < 8; ++j) { s += lfr[j]; cum[j] = s; } }
        SEG[seg * 64 + k] = cum[7];
        __syncthreads();
        float prefix = 0.f, btot = 0.f;
#pragma unroll
        for (int s = 0; s < 8; ++s) { const float x = SEG[s * 64 + k]; btot += x; prefix += (s < seg) ? x : 0.f; }
        { unsigned kep[4];
#pragma unroll
          for (int j = 0; j < 8; j += 2) {
              float ke2[2];
#pragma unroll
              for (int u = 0; u < 2; ++u) { const int jj = j + u; const float bb = prefix + cum[jj], f = ex2(lfr[jj] * LOG2E), kk = 1.0f - f;
                  const float qd = bf2f(qh[jj]) * ex2(bb * LOG2E), kd = kk * ex2(-bb * LOG2E); ke2[u] = kk * ex2((btot - bb) * LOG2E);
                  *(LAS bf16*)(lds + HG_QD + (8 * seg + jj) * HG_ROW + 2 * k) = (bf16)f2bf(qd);
                  *(LAS bf16*)(lds + HG_KD + (8 * seg + jj) * HG_ROW + 2 * k) = (bf16)f2bf(kd); }
              kep[j >> 1] = pk2(ke2[0], ke2[1]); }
          *(LAS v4u*)(lds + HG_KET + k * HG_ROW + 16 * seg) = (v4u){kep[0], kep[1], kep[2], kep[3]}; }
        if (seg == 0) DEC[k] = ex2(btot * LOG2E);
        *(LAS v4u*)(lds + HG_V + tB * HG_VS + 16 * c8) = vld;
        const v4u gcur = gld;
        __syncthreads();
        if (n + 1 < SEQ / 64) HG_LOAD(n + 1);
        if (wave < 4) {
            f32x16 p0, p1;
#pragma unroll
            for (int i = 0; i < 16; ++i) { p0[i] = 0.f; p1[i] = 0.f; }
#pragma unroll
            for (int ks = 0; ks < 4; ++ks) {
                const bf16x8 a0 = *(const LAS bf16x8*)(lds + HG_KD + krd + 32 * ks), a1 = *(const LAS bf16x8*)(lds + HG_KD + krd + 16 * HG_ROW + 32 * ks);
                const bf16x8 bq = *(const LAS bf16x8*)(lds + HG_QD + (32 * tb + r32) * HG_ROW + 32 * ks + 16 * hi);
                p0 = __builtin_amdgcn_mfma_f32_32x32x16_bf16(a0, bq, p0, 0, 0, 0);
                p1 = __builtin_amdgcn_mfma_f32_32x32x16_bf16(a1, bq, p1, 0, 0, 0);
            }
            const int tq = 32 * tb + r32;
            float e[32];
#pragma unroll
            for (int i = 0; i < 16; ++i) { e[i] = (32 * hi + i <= tq) ? p0[i] : 0.f; e[16 + i] = (32 * hi + 16 + i <= tq) ? p1[i] : 0.f; }
            bf16x8 pw[4];
#pragma unroll
            for (int j = 0; j < 4; ++j) { v4u w; w.x = pk2(e[8 * j], e[8 * j + 1]); w.y = pk2(e[8 * j + 2], e[8 * j + 3]); w.z = pk2(e[8 * j + 4], e[8 * j + 5]); w.w = pk2(e[8 * j + 6], e[8 * j + 7]); pw[j] = __builtin_bit_cast(bf16x8, w); }
            f32x16 o;
#pragma unroll
            for (int i = 0; i < 16; ++i) o[i] = 0.f;
#pragma unroll
            for (int kb = 0; kb < 2; ++kb)
#pragma unroll
                for (int s2 = 0; s2 < 2; ++s2) {
                    const f32x16& Sx = kb ? S1 : S0;
                    v4u aw; aw.x = pk2(Sx[8 * s2], Sx[8 * s2 + 1]); aw.y = pk2(Sx[8 * s2 + 2], Sx[8 * s2 + 3]); aw.z = pk2(Sx[8 * s2 + 4], Sx[8 * s2 + 5]); aw.w = pk2(Sx[8 * s2 + 6], Sx[8 * s2 + 7]);
                    const LAS unsigned char* qp = lds + HG_QD + (32 * tb + r32) * HG_ROW + (32 * kb + 16 * s2 + 4 * hi) * 2;
                    const v2u q0 = *(const LAS v2u*)qp, q1 = *(const LAS v2u*)(qp + 16);
                    const v4u bw = (v4u){q0.x, q0.y, q1.x, q1.y};
                    o = __builtin_amdgcn_mfma_f32_32x32x16_bf16(__builtin_bit_cast(bf16x8, aw), __builtin_bit_cast(bf16x8, bw), o, 0, 0, 0);
                }
#pragma unroll
            for (int j = 0; j < 4; ++j) {
                const bf16x8 vf = cat8(vtr(lds + HG_V + vrd_l + j * 8 * HG_VS), vtr(lds + HG_V + vrd_l + j * 8 * HG_VS + 4 * HG_VS));
                o = __builtin_amdgcn_mfma_f32_32x32x16_bf16(vf, pw[j], o, 0, 0, 0);
            }
#pragma unroll
            for (int g4 = 0; g4 < 4; ++g4) *(LAS f32x4*)(lds + HG_OB + tq * HG_OBS + (32 * vb + 8 * g4 + 4 * hi) * 4) = (f32x4){o[4 * g4], o[4 * g4 + 1], o[4 * g4 + 2], o[4 * g4 + 3]};
#pragma unroll
            for (int g4 = 0; g4 < 4; ++g4) { const f32x4 d0 = *(const LAS f32x4*)(DEC + 8 * g4 + 4 * hi), d1 = *(const LAS f32x4*)(DEC + 32 + 8 * g4 + 4 * hi);
#pragma unroll
                for (int i = 0; i < 4; ++i) { S0[4 * g4 + i] *= d0[i]; S1[4 * g4 + i] *= d1[i]; } }
#pragma unroll
            for (int ts = 0; ts < 4; ++ts) {
                const bf16x8 vf = cat8(vtr(lds + HG_V + vrd_n + ts * 16 * HG_VS), vtr(lds + HG_V + vrd_n + ts * 16 * HG_VS + 4 * HG_VS));
                const bf16x8 k0 = *(const LAS bf16x8*)(lds + HG_KET + r32 * HG_ROW + 32 * ts + 16 * hi), k1 = *(const LAS bf16x8*)(lds + HG_KET + (32 + r32) * HG_ROW + 32 * ts + 16 * hi);
                S0 = __builtin_amdgcn_mfma_f32_32x32x16_bf16(k0, vf, S0, 0, 0, 0);
                S1 = __builtin_amdgcn_mfma_f32_32x32x16_bf16(k1, vf, S1, 0, 0, 0);
            }
        }
        __syncthreads();
        {
            const f32x4 x0 = *(const LAS f32x4*)(lds + HG_OB + tB * HG_OBS + 32 * c8), x1 = *(const LAS f32x4*)(lds + HG_OB + tB * HG_OBS + 32 * c8 + 16);
            float ss = (x0.x * x0.x + x0.y * x0.y) + (x0.z * x0.z + x0.w * x0.w) + (x1.x * x1.x + x1.y * x1.y) + (x1.z * x1.z + x1.w * x1.w);
            ss += __shfl_xor(ss, 1); ss += __shfl_xor(ss, 2); ss += __shfl_xor(ss, 4);
            const float rstd = __builtin_amdgcn_rsqf(ss * (1.0f / 64.0f) + EPS);
            const f32x4 g0 = (f32x4){bflo(gcur.x), bfhi(gcur.x), bflo(gcur.y), bfhi(gcur.y)}, g1 = (f32x4){bflo(gcur.z), bfhi(gcur.z), bflo(gcur.w), bfhi(gcur.w)};
            const f32x4 y0 = x0 * rstd * gn0 * g0, y1 = x1 * rstd * gn1 * g1;
            *(v4u*)(MIX + (m0 + tB) * DM + 512 + 64 * h + 8 * c8) = pg8::pack8(y0, y1);
        }
    }
#undef HG_LOAD
    if (wave < 2) {
        float* so = a.out + O_SP + (size_t)(b * 8 + h) * 4096 + 32 * vb + r32;
#pragma unroll
        for (int r = 0; r < 16; ++r) { const int kr = (r & 3) + 8 * (r >> 2) + 4 * hi; so[(size_t)kr * 64] = S0[r]; so[(size_t)(32 + kr) * 64] = S1[r]; }
    }
    __syncthreads();
}

__global__ void __launch_bounds__(NWAVES * 64, 2) hymba_fwd(Args args) {
    extern __shared__ __attribute__((aligned(16))) unsigned char lds_raw[];
    LAS unsigned char* lds = (LAS unsigned char*)lds_raw;
    volatile LAS unsigned* MISC = (volatile LAS unsigned*)(lds + MISC_OFF);
    const int tid = threadIdx.x, lane = tid & 63, wave = __builtin_amdgcn_readfirstlane(tid >> 6);
    const int G = gridDim.x, bid = blockIdx.x;
    unsigned char* ws = args.ws;
    gu32* ctl = (gu32*)(ws + WS_CTL);
    for (int u = tid; u < (LDS_BYTES - LDSCTL_OFF) / 4; u += NWAVES * 64) ((LAS unsigned*)(lds + LDSCTL_OFF))[u] = 0u;
    __syncthreads();
    XcdBarrier bar; bar.bar = (unsigned*)(ctl + CW_BAR); bar.x = 0; bar.st = nullptr;
    if (N_LAUNCHES == 1) bar = xcd_barrier_post((unsigned*)(ctl + CW_BAR), MISC + 8);
#define GRID_BAR() do { if (N_LAUNCHES == 1) xcd_barrier(bar); } while (0)
    const int lo = args.ph_lo, hi = args.ph_hi;
#define IN(k) (lo <= (k) && (k) < hi)
    bf16* H = (bf16*)(ws + WS_H); float* ADA = (float*)(ws + WS_ADA); bf16* MIX = (bf16*)(ws + WS_MIX);

    if (IN(0)) { p0_prologue(args, lds, tid, lane, wave, bid, G); GRID_BAR(); }
    if (IN(1)) { norm_mod_phase(args.in[0], args.in[1], ADA, 0, 1024, args.in[10], H, lane, wave, bid, G); GRID_BAR(); }
    if (IN(2)) {
        pg8::Gemm g{H, (const bf16*)(ws + WS_WIN), MT, NIN, DM}; pg8::StaticOrder S; S.init(MT, NIN, G, bid);
        pg8::EpiInProj E{(bf16*)(ws + WS_Q), (bf16*)(ws + WS_K), (bf16*)(ws + WS_V), (bf16*)(ws + WS_HQ), (bf16*)(ws + WS_HV), (bf16*)(ws + WS_HG), (float*)(ws + WS_LF), args.out, args.in[13], args.in[14], args.in[16]};
        pg8::gemm_phase<pg8::EpiInProj, pg8::StaticOrder, true, true>(lds + RING_OFF, g, S, E);
        GRID_BAR();
    }
    if (IN(3)) {
        for (int u = bid; u < 256; u += G) { const int bh = u >> 2, pr = u & 3;
            attn_unit((const bf16*)(ws + WS_Q), (const bf16*)(ws + WS_K), (const bf16*)(ws + WS_V), MIX, args.in[15], lds, tid, lane, wave, bh >> 3, bh & 7, 7 - pr);
            attn_unit((const bf16*)(ws + WS_Q), (const bf16*)(ws + WS_K), (const bf16*)(ws + WS_V), MIX, args.in[15], lds, tid, lane, wave, bh >> 3, bh & 7, pr); }
        for (int it = bid; it < 256; it += G) dec_attn_item(args, it, lane, wave);
        GRID_BAR();
    }
    if (IN(4)) {
        const int first = G > 64 ? 64 : 0, nw = G > 64 ? G - 64 : G;
        if (bid < 64 || G <= 64) for (int ch = bid; ch < 64; ch += G) hgrn_chain(args, lds, tid, lane, wave, ch >> 3, ch & 7);
        if (bid >= first) for (int wi = (bid - first) * NWAVES + wave; wi < DB * 8; wi += nw * NWAVES) dec_hgrn_item(args, wi, lane);
        GRID_BAR();
    }
    if (IN(5)) {
        pg8::Gemm g{MIX, (const bf16*)(ws + WS_WOUT), MT, DM, DM}; pg8::StaticOrder S; S.init(MT, DM, G, bid);
        pg8::EpiResGate E{args.in[0], args.in[1], args.out, ADA, 2048};
        pg8::gemm_phase<pg8::EpiResGate, pg8::StaticOrder, true, true>(lds + RING_OFF, g, S, E);
        GRID_BAR();
    }
    if (IN(6)) { norm_mod_phase(args.out, args.out + (size_t)NP * DM, ADA, 3072, 4096, args.in[11], H, lane, wave, bid, G); GRID_BAR(); }
    if (IN(7)) {
        pg8::Gemm g{H, (const bf16*)(ws + WS_WUP), MT, DFF, DM}; pg8::StaticOrder S; S.init(MT, DFF, G, bid);
        pg8::EpiRelu2 E{(bf16*)(ws + WS_HUP), DFF};
        pg8::gemm_phase<pg8::EpiRelu2, pg8::StaticOrder, true, true>(lds + RING_OFF, g, S, E);
        GRID_BAR();
    }
    if (IN(8)) {
        pg8::Gemm g{(const bf16*)(ws + WS_HUP), (const bf16*)(ws + WS_WDN), MT, DM, DFF}; pg8::StaticOrder S; S.init(MT, DM, G, bid);
        pg8::EpiResGate E{args.out, args.out + (size_t)NP * DM, args.out, ADA, 5120};
        pg8::gemm_phase<pg8::EpiResGate, pg8::StaticOrder, true, true>(lds + RING_OFF, g, S, E);
    }
#undef IN
#undef GRID_BAR
}

extern "C" void kernel_launch(void* const* d_in, const int* in_sizes, int n_in, void* d_out, int out_size, void* d_ws, size_t ws_size, hipStream_t stream) {
    static int grid = 0;
    if (grid == 0) {
        if (n_in != 21 || in_sizes[0] != NP * DM || out_size != (int)O_END || ws_size < WS_END) { fprintf(stderr, "kernel_launch: unexpected shapes (n_in %d, in0 %d, out %d, ws %zu); nothing launched\n", n_in, n_in > 0 ? in_sizes[0] : -1, out_size, ws_size); grid = -1; return; }
        int dev = 0, cus = 0, per_cu = 0;
        if (hipGetDevice(&dev) != hipSuccess || hipDeviceGetAttribute(&cus, hipDeviceAttributeMultiprocessorCount, dev) != hipSuccess) { fprintf(stderr, "kernel_launch: device query failed\n"); grid = -1; return; }
        if (hipFuncSetAttribute((const void*)hymba_fwd, hipFuncAttributeMaxDynamicSharedMemorySize, LDS_BYTES) != hipSuccess) { fprintf(stderr, "kernel_launch: hipFuncSetAttribute failed\n"); grid = -1; return; }
        if (hipOccupancyMaxActiveBlocksPerMultiprocessor(&per_cu, (const void*)hymba_fwd, NWAVES * 64, LDS_BYTES) != hipSuccess || per_cu < 1)
            fprintf(stderr, "kernel_launch: note: occupancy query reports %d workgroups per CU\n", per_cu);
        (void)hipGetLastError();
        grid = cus;
    }
    if (grid < 0) return;
    if (hipMemsetAsync((char*)d_ws + WS_CTL, 0, CTL_ZERO_BYTES, stream) != hipSuccess) { fprintf(stderr, "kernel_launch: memset failed\n"); return; }
    Args a{};
    for (int i = 0; i < 21; ++i) a.in[i] = (const float*)d_in[i];
    a.out = (float*)d_out; a.ws = (unsigned char*)d_ws;
    if (N_LAUNCHES == 1) { a.ph_lo = 0; a.ph_hi = NPHASE; hipLaunchKernelGGL(hymba_fwd, dim3(grid), dim3(NWAVES * 64), LDS_BYTES, stream, a); }
    else for (int li = 0; li < NPHASE; ++li) { a.ph_lo = li; a.ph_hi = li + 1; hipLaunchKernelGGL(hymba_fwd, dim3(grid), dim3(NWAVES * 64), LDS_BYTES, stream, a); }
    const hipError_t le = hipPeekAtLastError();
    if (le != hipSuccess) fprintf(stderr, "kernel_launch: launch failed: %s\n", hipGetErrorName(le));
}
```

```cpp
#include <hip/hip_runtime.h>
#include <cstdio>
#include <cstdint>
namespace cfg {
constexpr int DM = 1024, NP = 16384, NS = 512, MT = NP + NS, NIN = 3584, DFF = 4096, NADA = 6144, NADAROW = 136;
constexpr int SEQ = 2048, DB = 128, DSQ = 4, PAST = 2048, PAGE = 128, NPAGE = 16;
constexpr float EPS = 1e-6f;
constexpr float LOG2E = 1.4426950408889634f;
constexpr float QSCALE = 0.125f * LOG2E;
constexpr size_t O_Y = 0, O_KP = 17301504, O_VP = 25690112, O_KS = 34078720, O_VS = 34340864, O_SP = 34603008, O_SS = 34865152, O_END = 39059456;
}
namespace pg8 {
#define PG8_LAS __attribute__((address_space(3)))
typedef unsigned short bf16_t;
typedef short bf16x8 __attribute__((ext_vector_type(8)));
typedef float f32x4 __attribute__((ext_vector_type(4)));
typedef unsigned u32x4 __attribute__((ext_vector_type(4)));
constexpr int BM = 256, BK = 64, HALF = 128, HTB = HALF * BK * 2  , STAGE_BYTES = 8 * HTB, NXCD = 8, WGM = 8;

__host__ __device__ __forceinline__ int lds_byte(int r, int c) { const int st = (r >> 4) * 2 + (c >> 5), rr = r & 15, cc = c & 31, ob = rr * 64 + cc * 2; return st * 1024 + (ob ^ (((ob >> 9) & 1) << 5)); }
__host__ __device__ __forceinline__ void stage_rc(int b, int& R, int& C) { const int st = b / 1024, sb = b % 1024, swz = sb ^ (((sb >> 9) & 1) << 5); R = (st >> 1) * 16 + swz / 64; C = (st & 1) * 32 + (swz % 64) / 2; }
__host__ __device__ __forceinline__ int perm32(int rho) { const int n = rho >> 4, i = rho & 15; return 8 * (i >> 2) + 4 * n + (i & 3); }

struct Unit { int pm, pn; };
struct Gemm { const bf16_t* A; const bf16_t* Bt; int M, N, K; };

struct StaticOrder {
    int nM, nN, nwg, G, c;
    __host__ __device__ void init(int M, int N, int G_, int c_) { nM = M / BM; nN = N / BM; nwg = nM * nN; G = G_; c = c_; }
    __host__ __device__ bool next(int i, Unit& u) const {
        const long L = (long)i * G + c; if (L >= nwg) return false;
        int wgid = (int)L; { const int q = nwg / NXCD, r = nwg % NXCD, xcd = wgid % NXCD, off = wgid / NXCD; wgid = (xcd < r ? xcd * (q + 1) : r * (q + 1) + (xcd - r) * q) + off; }
        const int nig = WGM * nN, gid = wgid / nig, fm = gid * WGM, gsz = (nM - fm) < WGM ? (nM - fm) : WGM;
        u.pm = fm + ((wgid % nig) % gsz); u.pn = (wgid % nig) / gsz; return true;
    }
    __device__ __forceinline__ void a_ready(const Unit&) const {}
    __device__ __forceinline__ void done(const Unit&) const {}
};


__device__ __forceinline__ unsigned cvt_pk_bf16(float lo, float hi) { unsigned r; asm volatile("v_cvt_pk_bf16_f32 %0, %1, %2" : "=v"(r) : "v"(lo), "v"(hi)); return r; }
__device__ __forceinline__ float ex2(float x) { return __builtin_amdgcn_exp2f(x); }
__device__ __forceinline__ float rcpf_(float x) { return __builtin_amdgcn_rcpf(x); }
__device__ __forceinline__ float sigm(float x) { return rcpf_(1.0f + ex2(x * -1.4426950408889634f)); }
__device__ __forceinline__ u32x4 pack8(f32x4 a, f32x4 b) { u32x4 w; w.x = cvt_pk_bf16(a[0], a[1]); w.y = cvt_pk_bf16(a[2], a[3]); w.z = cvt_pk_bf16(b[0], b[1]); w.w = cvt_pk_bf16(b[2], b[3]); return w; }

struct EpiInProj {
    static constexpr bool PERM = true, AFTER_DRAIN = false;
    bf16_t *Qb, *Kb, *Vb, *HQ, *HV, *HG; float* LF; float* out; const float *qg, *kg, *lbl;
    __device__ __forceinline__ void operator()(const f32x4 (&acc)[2][2][4][2], const Unit& u, int wr, int wc, int fr, int fq) const {
        const int type = u.pn >> 1, head = (u.pn & 1) * 4 + wc;
        const int row0 = u.pm * BM + wr * 64 + fr;
        const int fcol = head * 64 + 8 * fq;
        const bool prompt = u.pm < cfg::NP / BM;
        if (type <= 1) {
            const float* g = type == 0 ? qg : kg;
            f32x4 gv[2][2];
#pragma unroll
            for (int bj = 0; bj < 2; ++bj)
#pragma unroll
                for (int n = 0; n < 2; ++n) gv[bj][n] = *(const f32x4*)(g + 32 * bj + 8 * fq + 4 * n);
            const float post = type == 0 ? cfg::QSCALE : 1.0f;
            bf16_t* ob = type == 0 ? Qb : Kb;
            float* kof = prompt ? out + cfg::O_KP : out + cfg::O_KS - (size_t)cfg::NP * 512;
#pragma unroll
            for (int ai = 0; ai < 2; ++ai)
#pragma unroll
                for (int m = 0; m < 4; ++m) {
                    float ss = 0.f;
#pragma unroll
                    for (int bj = 0; bj < 2; ++bj)
#pragma unroll
                        for (int n = 0; n < 2; ++n) { const f32x4 x = acc[ai][bj][m][n]; ss += (x[0] * x[0] + x[1] * x[1]) + (x[2] * x[2] + x[3] * x[3]); }
                    ss += __shfl_xor(ss, 16); ss += __shfl_xor(ss, 32);
                    const float rstd = __builtin_amdgcn_rsqf(ss * (1.0f / 64.0f) + cfg::EPS);
                    const size_t row = (size_t)(row0 + ai * HALF + m * 16);
#pragma unroll
                    for (int bj = 0; bj < 2; ++bj) {
                        const f32x4 v0 = acc[ai][bj][m][0] * rstd * gv[bj][0], v1 = acc[ai][bj][m][1] * rstd * gv[bj][1];
                        if (type == 1) { float* kp = kof + row * 512 + fcol + 32 * bj; *(f32x4*)kp = v0; *(f32x4*)(kp + 4) = v1; }
                        *(u32x4*)(ob + row * 512 + fcol + 32 * bj) = pack8(v0 * post, v1 * post);
                    }
                }
        } else if (type == 2) {
            float* vof = prompt ? out + cfg::O_VP : out + cfg::O_VS - (size_t)cfg::NP * 512;
#pragma unroll
            for (int ai = 0; ai < 2; ++ai)
#pragma unroll
                for (int m = 0; m < 4; ++m) { const size_t row = (size_t)(row0 + ai * HALF + m * 16);
#pragma unroll
                    for (int bj = 0; bj < 2; ++bj) { const f32x4 v0 = acc[ai][bj][m][0], v1 = acc[ai][bj][m][1];
                        float* vp = vof + row * 512 + fcol + 32 * bj; *(f32x4*)vp = v0; *(f32x4*)(vp + 4) = v1;
                        *(u32x4*)(Vb + row * 512 + fcol + 32 * bj) = pack8(v0, v1); } }
        } else if (type == 4) {
            f32x4 lb[2][2];
#pragma unroll
            for (int bj = 0; bj < 2; ++bj)
#pragma unroll
                for (int n = 0; n < 2; ++n) { const f32x4 l0 = *(const f32x4*)(lbl + fcol + 32 * bj + 4 * n), l1 = *(const f32x4*)(lbl + 512 + fcol + 32 * bj + 4 * n);
#pragma unroll
                    for (int i = 0; i < 4; ++i) lb[bj][n][i] = sigm(l0[i] - l1[i]); }
#pragma unroll
            for (int ai = 0; ai < 2; ++ai)
#pragma unroll
                for (int m = 0; m < 4; ++m) { const size_t row = (size_t)(row0 + ai * HALF + m * 16);
#pragma unroll
                    for (int bj = 0; bj < 2; ++bj)
#pragma unroll
                        for (int n = 0; n < 2; ++n) { f32x4 o;
#pragma unroll
                            for (int i = 0; i < 4; ++i) { const float l = lb[bj][n][i], f = l + (1.0f - l) * sigm(acc[ai][bj][m][n][i]); o[i] = __builtin_amdgcn_logf(f) * 0.6931471805599453f; }
                            *(f32x4*)(LF + row * 512 + fcol + 32 * bj + 4 * n) = o; } }
        } else {
            bf16_t* ob = type == 3 ? HQ : (type == 5 ? HV : HG);
            const bool act = type != 5;
#pragma unroll
            for (int ai = 0; ai < 2; ++ai)
#pragma unroll
                for (int m = 0; m < 4; ++m) { const size_t row = (size_t)(row0 + ai * HALF + m * 16);
#pragma unroll
                    for (int bj = 0; bj < 2; ++bj) { f32x4 v0 = acc[ai][bj][m][0], v1 = acc[ai][bj][m][1];
                        if (act) {
#pragma unroll
                            for (int i = 0; i < 4; ++i) { v0[i] = v0[i] * sigm(v0[i]); v1[i] = v1[i] * sigm(v1[i]); } }
                        *(u32x4*)(ob + row * 512 + fcol + 32 * bj) = pack8(v0, v1); } }
        }
    }
};
struct EpiResGate {
    static constexpr bool PERM = true, AFTER_DRAIN = false;
    const float *base_p, *base_s; float* out; const float* ada; int goff;
    __device__ __forceinline__ void operator()(const f32x4 (&acc)[2][2][4][2], const Unit& u, int wr, int wc, int fr, int fq) const {
        const int row0 = u.pm * BM + wr * 64 + fr, col0 = u.pn * BM + wc * 32 + 8 * fq;
#pragma unroll
        for (int ai = 0; ai < 2; ++ai)
#pragma unroll
            for (int m = 0; m < 4; ++m) { const int row = row0 + ai * HALF + m * 16;
                const int ar = row < cfg::NP ? (row >> 11) : 8 + ((row - cfg::NP) >> 2);
                const float* bp = row < cfg::NP ? base_p + (size_t)row * 1024 : base_s + (size_t)(row - cfg::NP) * 1024;
                const float* gp = ada + (size_t)ar * cfg::NADA + goff; float* op = out + (size_t)row * 1024;
#pragma unroll
                for (int bj = 0; bj < 2; ++bj)
#pragma unroll
                    for (int n = 0; n < 2; ++n) { const int c = col0 + bj * HALF + 4 * n; const f32x4 x = *(const f32x4*)(bp + c), g = *(const f32x4*)(gp + c);
                        *(f32x4*)(op + c) = x + g * acc[ai][bj][m][n]; } }
    }
};
struct EpiRelu2 {
    static constexpr bool PERM = true, AFTER_DRAIN = false;
    bf16_t* O; int ldc;
    __device__ __forceinline__ void operator()(const f32x4 (&acc)[2][2][4][2], const Unit& u, int wr, int wc, int fr, int fq) const {
        const int row0 = u.pm * BM + wr * 64 + fr, col0 = u.pn * BM + wc * 32 + 8 * fq;
#pragma unroll
        for (int ai = 0; ai < 2; ++ai)
#pragma unroll
            for (int m = 0; m < 4; ++m) { bf16_t* rowp = O + (size_t)(row0 + ai * HALF + m * 16) * ldc + col0;
#pragma unroll
                for (int bj = 0; bj < 2; ++bj) { f32x4 v0 = acc[ai][bj][m][0], v1 = acc[ai][bj][m][1];
#pragma unroll
                    for (int i = 0; i < 4; ++i) { const float a = fmaxf(v0[i], 0.f), b = fmaxf(v1[i], 0.f); v0[i] = a * a; v1[i] = b * b; }
                    *(u32x4*)(rowp + bj * HALF) = pack8(v0, v1); } }
    }
};

template <class Epi, class Sched, bool ALIGN_EPI = false, bool SP2 = false>
__device__ __forceinline__ void gemm_phase(PG8_LAS unsigned char* lds, const Gemm g, const Sched& S, const Epi& E) {
    const int tid = threadIdx.x, wid = __builtin_amdgcn_readfirstlane(tid >> 6), lane = tid & 63, wr = wid >> 2, wc = wid & 3, fr = lane & 15, fq = lane >> 4;
    const int K = g.K, nt = K / BK;
    unsigned voffA[2], voffB[2];
#pragma unroll
    for (int i = 0; i < 2; ++i) { int R, C; stage_rc(tid * 16 + i * 8192, R, C); const int Rb = Epi::PERM ? ((R & ~31) + perm32(R & 31)) : R;
        voffA[i] = (unsigned)(R * K + C) * 2u; voffB[i] = (unsigned)(Rb * K + C) * 2u; }
    const size_t kstep = (size_t)(BK * 2);
    const size_t hstep = (size_t)HALF * K * 2;
    const size_t tstep = 2 * hstep;
    const unsigned ldsw = (unsigned)wid * 1024u;
    const int aoff = lds_byte(wr * 64 + fr, fq * 8), boff = lds_byte(wc * 32 + fr, fq * 8);
#define PG8_SA(b, h) (((b) * 2 + (h)) * HTB)
#define PG8_SB(b, h) ((4 + (b) * 2 + (h)) * HTB)
#define PG8_STAGE(bufoff, gbase, voff) do { _Pragma("unroll") for (int _i = 0; _i < 2; ++_i) \
        __builtin_amdgcn_global_load_lds((const unsigned*)((const char*)(gbase) + (voff)[_i]), (PG8_LAS unsigned*)(lds + (bufoff) + ldsw + _i * 8192), 16, 0, 0); } while (0)
#define PG8_LDA(dst, b, h) do { _Pragma("unroll") for (int m = 0; m < 4; ++m) _Pragma("unroll") for (int k = 0; k < 2; ++k) dst[m][k] = *(const PG8_LAS bf16x8*)(lds + PG8_SA(b, h) + aoff + m * 2048 + k * 1024); } while (0)
#define PG8_LDB(dst, b, h) do { _Pragma("unroll") for (int n = 0; n < 2; ++n) _Pragma("unroll") for (int k = 0; k < 2; ++k) dst[n][k] = *(const PG8_LAS bf16x8*)(lds + PG8_SB(b, h) + boff + n * 2048 + k * 1024); } while (0)
#define PG8_MMA(ai, bj, At, Bt) do { __builtin_amdgcn_s_setprio(1); _Pragma("unroll") for (int m = 0; m < 4; ++m) _Pragma("unroll") for (int n = 0; n < 2; ++n) _Pragma("unroll") for (int k = 0; k < 2; ++k) \
        acc[ai][bj][m][n] = __builtin_amdgcn_mfma_f32_16x16x32_bf16(Bt[n][k], At[m][k], acc[ai][bj][m][n], 0, 0, 0); __builtin_amdgcn_s_setprio(0); } while (0)
#define PG8_WAIT_V(n) asm volatile("s_waitcnt vmcnt(" #n ")" ::: "memory")
#define PG8_WAIT_L(n) asm volatile("s_waitcnt lgkmcnt(" #n ")" ::: "memory")
#define PG8_BAR __builtin_amdgcn_s_barrier()
#define PG8_SCHED __builtin_amdgcn_sched_barrier(0)
    Unit cur, nxt; int ui = 0;
    if (!S.next(0, cur)) return;
    f32x4 acc[2][2][4][2];
#pragma unroll
    for (int a = 0; a < 2; ++a)
#pragma unroll
        for (int b = 0; b < 2; ++b)
#pragma unroll
            for (int m = 0; m < 4; ++m)
#pragma unroll
                for (int n = 0; n < 2; ++n) acc[a][b][m][n] = (f32x4){0.f, 0.f, 0.f, 0.f};
    bf16x8 At[4][2], B0[2][2], B1[2][2];
    const char* cA = (const char*)g.A + (size_t)cur.pm * tstep; const char* cB = (const char*)g.Bt + (size_t)cur.pn * tstep;
    S.a_ready(cur);
    if constexpr (SP2) {
        PG8_STAGE(PG8_SB(0, 0), cB, voffB); PG8_STAGE(PG8_SB(0, 1), cB + hstep, voffB); PG8_STAGE(PG8_SA(0, 0), cA, voffA); PG8_STAGE(PG8_SA(0, 1), cA + hstep, voffA);
        if (wr == 1) PG8_BAR;
        PG8_WAIT_V(2); PG8_BAR;
        PG8_STAGE(PG8_SB(1, 0), cB + kstep, voffB); PG8_STAGE(PG8_SA(1, 0), cA + kstep, voffA); PG8_STAGE(PG8_SB(1, 1), cB + hstep + kstep, voffB);
        PG8_WAIT_V(6); PG8_BAR;
    } else {
        PG8_STAGE(PG8_SB(0, 0), cB, voffB); PG8_STAGE(PG8_SA(0, 0), cA, voffA); PG8_STAGE(PG8_SB(0, 1), cB + hstep, voffB); PG8_STAGE(PG8_SA(0, 1), cA + hstep, voffA);
        if (wr == 1) PG8_BAR;
        PG8_WAIT_V(4); PG8_BAR;
        PG8_STAGE(PG8_SB(1, 0), cB + kstep, voffB); PG8_STAGE(PG8_SA(1, 0), cA + kstep, voffA); PG8_STAGE(PG8_SB(1, 1), cB + hstep + kstep, voffB);
        PG8_WAIT_V(6); PG8_BAR;
    }
    for (;;) {
        const bool has_next = S.next(ui + 1, nxt);
        const char* nA = has_next ? (const char*)g.A + (size_t)nxt.pm * tstep : cA; const char* nB = has_next ? (const char*)g.Bt + (size_t)nxt.pn * tstep : cB;
        for (int t = 0; t < nt; t += 2) {
            const bool last = (t == nt - 2);
            const char* a1 = cA + (size_t)(t + 1) * kstep;
            const char* a2 = last ? nA : cA + (size_t)(t + 2) * kstep; const char* b2 = last ? nB : cB + (size_t)(t + 2) * kstep;
            const char* a3 = a2 + kstep; const char* b3 = b2 + kstep;
            if (last && has_next) S.a_ready(nxt);
            if constexpr (SP2) {
            PG8_LDB(B0, 0, 0); PG8_LDB(B1, 0, 1); PG8_SCHED; PG8_LDA(At, 0, 0); PG8_STAGE(PG8_SA(1, 1), a1 + hstep, voffA);
            PG8_WAIT_V(8); PG8_WAIT_L(0); PG8_BAR; PG8_MMA(0, 0, At, B0); PG8_MMA(0, 1, At, B1); PG8_BAR; PG8_SCHED;
            PG8_LDA(At, 0, 1); PG8_STAGE(PG8_SB(0, 0), b2, voffB); PG8_STAGE(PG8_SB(0, 1), b2 + hstep, voffB); PG8_STAGE(PG8_SA(0, 0), a2, voffA);
            PG8_WAIT_V(8); PG8_WAIT_L(0); PG8_BAR; PG8_MMA(1, 0, At, B0); PG8_MMA(1, 1, At, B1); PG8_BAR; PG8_SCHED;
            PG8_LDB(B0, 1, 0); PG8_LDB(B1, 1, 1); PG8_SCHED; PG8_LDA(At, 1, 0); PG8_STAGE(PG8_SA(0, 1), a2 + hstep, voffA);
            PG8_WAIT_V(8); PG8_WAIT_L(0); PG8_BAR; PG8_MMA(0, 0, At, B0); PG8_MMA(0, 1, At, B1); PG8_BAR; PG8_SCHED;
            PG8_LDA(At, 1, 1); PG8_STAGE(PG8_SB(1, 0), b3, voffB); PG8_STAGE(PG8_SB(1, 1), b3 + hstep, voffB); PG8_STAGE(PG8_SA(1, 0), a3, voffA);
            PG8_WAIT_V(8); PG8_WAIT_L(0); PG8_BAR; PG8_MMA(1, 0, At, B0); PG8_MMA(1, 1, At, B1); PG8_BAR; PG8_SCHED;
            } else {
            PG8_LDB(B0, 0, 0); PG8_SCHED; PG8_LDA(At, 0, 0); PG8_STAGE(PG8_SA(1, 1), a1 + hstep, voffA);
            PG8_WAIT_L(8); PG8_BAR; PG8_WAIT_L(0); PG8_MMA(0, 0, At, B0); PG8_BAR; PG8_SCHED;
            PG8_LDB(B1, 0, 1); PG8_STAGE(PG8_SB(0, 0), b2, voffB);
            PG8_BAR; PG8_WAIT_L(0); PG8_MMA(0, 1, At, B1); PG8_BAR;
            PG8_LDA(At, 0, 1); PG8_STAGE(PG8_SA(0, 0), a2, voffA);
            PG8_BAR; PG8_WAIT_L(0); PG8_MMA(1, 0, At, B0); PG8_BAR; PG8_SCHED;
            PG8_STAGE(PG8_SB(0, 1), b2 + hstep, voffB);
            PG8_WAIT_V(6); PG8_BAR; PG8_MMA(1, 1, At, B1); PG8_BAR;
            PG8_LDB(B0, 1, 0); PG8_SCHED; PG8_LDA(At, 1, 0); PG8_STAGE(PG8_SA(0, 1), a2 + hstep, voffA);
            PG8_WAIT_L(8); PG8_BAR; PG8_WAIT_L(0); PG8_MMA(0, 0, At, B0); PG8_BAR; PG8_SCHED;
            PG8_LDB(B1, 1, 1); PG8_STAGE(PG8_SB(1, 0), b3, voffB);
            PG8_BAR; PG8_WAIT_L(0); PG8_MMA(0, 1, At, B1); PG8_BAR;
            PG8_LDA(At, 1, 1); PG8_STAGE(PG8_SA(1, 0), a3, voffA);
            PG8_BAR; PG8_WAIT_L(0); PG8_MMA(1, 0, At, B0); PG8_BAR; PG8_SCHED;
            PG8_STAGE(PG8_SB(1, 1), b3 + hstep, voffB);
            PG8_WAIT_V(6); PG8_BAR; PG8_MMA(1, 1, At, B1); PG8_BAR;
            }
        }
        if constexpr (ALIGN_EPI) { if (wr == 0) PG8_BAR; }
        if constexpr (!Epi::AFTER_DRAIN) { E(acc, cur, wr, wc, fr, fq); S.done(cur); }
        if (!has_next) break;
#pragma unroll
        for (int a = 0; a < 2; ++a)
#pragma unroll
            for (int b = 0; b < 2; ++b)
#pragma unroll
                for (int m = 0; m < 4; ++m)
#pragma unroll
                    for (int n = 0; n < 2; ++n) acc[a][b][m][n] = (f32x4){0.f, 0.f, 0.f, 0.f};
        cur = nxt; cA = nA; cB = nB; ++ui;
        if constexpr (ALIGN_EPI) { if (wr == 1) PG8_BAR; }
    }
    PG8_WAIT_V(0);
    if constexpr (!ALIGN_EPI) { if (wr == 0) PG8_BAR; }
    PG8_BAR;
    if constexpr (Epi::AFTER_DRAIN) { E.fused(acc, cur, wr, wc, fr, fq, lds, wid, lane); S.done(cur); }
#undef PG8_SA
#undef PG8_SB
#undef PG8_STAGE
#undef PG8_LDA
#undef PG8_LDB
#undef PG8_MMA
#undef PG8_WAIT_V
#undef PG8_WAIT_L
#undef PG8_BAR
#undef PG8_SCHED
}
}

constexpr int NWAVES = 8;
#ifndef MK_N_LAUNCHES
#define MK_N_LAUNCHES 1
#endif
constexpr int N_LAUNCHES = MK_N_LAUNCHES;
constexpr int NPHASE = 9;
using namespace cfg;

constexpr size_t MiB = 1u << 20;
constexpr size_t WS_CTL = 0, CTL_ZERO_BYTES = 1 * MiB;
constexpr size_t WS_WIN = 2 * MiB, WS_WOUT = 9 * MiB, WS_WUP = 11 * MiB, WS_WDN = 19 * MiB;
constexpr size_t WS_ADA = 27 * MiB;
constexpr size_t WS_DPO = 31 * MiB, WS_DPP = 34 * MiB;
constexpr size_t WS_H = 36 * MiB;
constexpr size_t WS_Q = 70 * MiB, WS_K = 87 * MiB, WS_V = 104 * MiB, WS_HQ = 121 * MiB, WS_HV = 138 * MiB, WS_HG = 155 * MiB;
constexpr size_t WS_LF = 172 * MiB;
constexpr size_t WS_MIX = 205 * MiB;
constexpr size_t WS_HUP = 240 * MiB, WS_END = 372 * MiB;
constexpr int CW_BAR = 4096, CW_Q = 8192;

constexpr int RING_OFF = 0, RING_BYTES = 131072;
constexpr int LDSCTL_OFF = RING_BYTES, MISC_OFF = LDSCTL_OFF + 320;
constexpr int LDS_BYTES = 147456;

#define GAS __attribute__((address_space(1)))
#define LAS __attribute__((address_space(3)))
typedef unsigned short bf16;
typedef unsigned v4u __attribute__((ext_vector_type(4)));
typedef unsigned v2u __attribute__((ext_vector_type(2)));
typedef float f32x4 __attribute__((ext_vector_type(4)));
typedef float f32x16 __attribute__((ext_vector_type(16)));
typedef short bf16x8 __attribute__((ext_vector_type(8)));
typedef short s16x4 __attribute__((ext_vector_type(4)));
typedef GAS unsigned gu32;
#define RLX_AGENT __ATOMIC_RELAXED, __HIP_MEMORY_SCOPE_AGENT
#define LDS_WAIT() asm volatile("s_waitcnt lgkmcnt(0)" ::: "memory")
#define VM_WAIT() asm volatile("s_waitcnt vmcnt(0)" ::: "memory")
__device__ __forceinline__ unsigned f2bf(float f) { unsigned u = __builtin_bit_cast(unsigned, f); return (u + 0x7fffu + ((u >> 16) & 1u)) >> 16; }
__device__ __forceinline__ unsigned pk2(float lo, float hi) { return pg8::cvt_pk_bf16(lo, hi); }
__device__ __forceinline__ float bf2f(unsigned short b) { return __builtin_bit_cast(float, (unsigned)b << 16); }
__device__ __forceinline__ float bflo(unsigned w) { return __builtin_bit_cast(float, w << 16); }
__device__ __forceinline__ float bfhi(unsigned w) { return __builtin_bit_cast(float, w & 0xffff0000u); }
using pg8::ex2; using pg8::rcpf_; using pg8::sigm;
__device__ __forceinline__ float wave_sum(float v) {
#pragma unroll
    for (int o = 1; o < 64; o <<= 1) v += __shfl_xor(v, o);
    return v;
}
__device__ __forceinline__ s16x4 vtr(const LAS unsigned char* p) { return __builtin_bit_cast(s16x4, __builtin_amdgcn_ds_read_tr16_b64_v4i16((LAS s16x4*)p)); }
__device__ __forceinline__ bf16x8 cat8(s16x4 a, s16x4 b) { return (bf16x8){a[0], a[1], a[2], a[3], b[0], b[1], b[2], b[3]}; }

#define XB_TMO      128
#define XB_XCNT(j)  (256  + 64 * (j))
#define XB_XSUB(j)  (1280 + 64 * (j))
#define XB_XGEN(j)  (2304 + 64 * (j))
#define XB_TOP      3328
#define XB_TOPGEN   3392
#define XCD_BAR_WORDS 3456
#define XB_SPIN_CAP (1u << 18)

__device__ __forceinline__ unsigned xb_ld(unsigned* p)              { return __hip_atomic_load(p, __ATOMIC_RELAXED, __HIP_MEMORY_SCOPE_AGENT); }
__device__ __forceinline__ unsigned xb_add(unsigned* p, unsigned v) { return __hip_atomic_fetch_add(p, v, __ATOMIC_RELAXED, __HIP_MEMORY_SCOPE_AGENT); }
__device__ __forceinline__ unsigned xb_xcc_id() { return (unsigned)__builtin_amdgcn_s_getreg((3 << 11) | 20) & 0xFu; }
#define XB_SPIN(cond, bar) do { unsigned _sp = 0; while (cond) { __builtin_amdgcn_s_sleep(1); \
    if ((++_sp & 255u) == 0u) { if (xb_ld(&(bar)[XB_TMO])) break; if (_sp > XB_SPIN_CAP) { atomicAdd(&(bar)[XB_TMO], 1u); break; } } } } while (0)

struct XcdBarrier {
    unsigned* bar; unsigned x;
    volatile LAS unsigned* st;
};

__device__ __forceinline__ XcdBarrier xcd_barrier_post(unsigned* bar, volatile LAS unsigned* st) {
    XcdBarrier b; b.bar = bar; b.x = xb_xcc_id(); b.st = st;
    if (threadIdx.x == 0) (void)xb_add(&bar[XB_XCNT(b.x)], 1u);
    return b;
}
__device__ __forceinline__ void xcd_barrier_complete(unsigned* bar, unsigned x, unsigned& nloc, unsigned& nx) {
    const unsigned G = gridDim.x * gridDim.y * gridDim.z;
    unsigned sum, cnt, mine, sp = 0u;
    for (;;) {
        sum = 0u; cnt = 0u; mine = 0u;
#pragma unroll
        for (unsigned j = 0; j < 16; ++j) { const unsigned c = xb_ld(&bar[XB_XCNT(j)]); sum += c; cnt += (c > 0u) ? 1u : 0u; mine = (j == x) ? c : mine; }
        if (sum == G) break;
        __builtin_amdgcn_s_sleep(1);
        if ((++sp & 255u) == 0u) { if (xb_ld(&bar[XB_TMO])) break; if (sp > XB_SPIN_CAP) { atomicAdd(&bar[XB_TMO], 1u); break; } }
    }
    nloc = mine > 0u ? mine : 1u; nx = cnt > 0u ? cnt : 1u;
}

__device__ __forceinline__ void xcd_barrier(const XcdBarrier& b) {
    asm volatile("s_waitcnt vmcnt(0)" ::: "memory");
    __syncthreads();
    if (threadIdx.x == 0) {
        unsigned* bar = b.bar;
        __builtin_amdgcn_s_waitcnt(0);
        unsigned nloc = b.st[0], nx = b.st[1];
        if (nloc == 0u) { xcd_barrier_complete(bar, b.x, nloc, nx); b.st[0] = nloc; b.st[1] = nx; }
        const unsigned old = xb_add(&bar[XB_XSUB(b.x)], 1u);
        const unsigned gen = old / nloc;
        if (old + 1u == (gen + 1u) * nloc) {
            __builtin_amdgcn_fence(__ATOMIC_RELEASE, "agent");
            asm volatile("s_waitcnt vmcnt(0)" ::: "memory");
            const unsigned og = xb_add(&bar[XB_TOP], 1u);
            const unsigned tg = og / nx;
            if (og + 1u == (tg + 1u) * nx) xb_add(&bar[XB_TOPGEN], 1u);
            else XB_SPIN(xb_ld(&bar[XB_TOPGEN]) == tg, bar);
            __builtin_amdgcn_fence(__ATOMIC_ACQUIRE, "agent");
            xb_add(&bar[XB_XGEN(b.x)], 1u);
            asm volatile("s_waitcnt vmcnt(0)" ::: "memory");
        } else {
            XB_SPIN(xb_ld(&bar[XB_XGEN(b.x)]) == gen, bar);
            __builtin_amdgcn_fence(__ATOMIC_ACQUIRE, "agent");
            asm volatile("s_waitcnt vmcnt(0)" ::: "memory");
        }
    }
    __syncthreads();
}

struct Args { const float* in[21]; float* out; unsigned char* ws; int ph_lo, ph_hi; };

__device__ __forceinline__ void p0_transpose_item(const float* W, int K, int N, bf16* WT, bool headperm, LAS float* scr, int item, int lane) {
    const int nblk = N / 32, kb = item / nblk, nb = item % nblk, k0 = 64 * kb, n0 = 32 * nb;
#pragma unroll 8
    for (int i = 0; i < 32; ++i) { const int kk = 2 * i + (lane >> 5); scr[kk * 33 + (lane & 31)] = W[(size_t)(k0 + kk) * N + n0 + (lane & 31)]; }
    LDS_WAIT(); asm volatile("" ::: "memory");
    int drow0 = n0;
    if (headperm) { const int g = (n0 & 255) >> 5; drow0 = (n0 & ~255) + 32 * (4 * (g & 1) + (g >> 1)); }
    const int c = lane & 7;
#pragma unroll
    for (int j = 0; j < 4; ++j) { const int n = (lane >> 3) + 8 * j; const LAS float* s = scr + (8 * c) * 33 + n;
        v4u o; o.x = pk2(s[0 * 33], s[1 * 33]); o.y = pk2(s[2 * 33], s[3 * 33]); o.z = pk2(s[4 * 33], s[5 * 33]); o.w = pk2(s[6 * 33], s[7 * 33]);
        *(GAS v4u*)(WT + (size_t)(drow0 + n) * K + k0 + 8 * c) = o; }
    LDS_WAIT(); asm volatile("" ::: "memory");
}
__device__ __forceinline__ float siluf(float x) { return x * sigm(x); }
__device__ __forceinline__ void p0_prologue(const Args& a, LAS unsigned char* lds, int tid, int lane, int wave, int bid, int G) {
    unsigned char* ws = a.ws;
    {
        LAS float* scr = (LAS float*)(lds + RING_OFF + wave * 16384);
        const int gw = bid * NWAVES + wave, NGW = G * NWAVES;
        constexpr int I_IN = (DM / 64) * (NIN / 32), I_OUT = (DM / 64) * (DM / 32), I_UP = (DM / 64) * (DFF / 32), I_DN = (DFF / 64) * (DM / 32);
        constexpr int NITEMS = I_IN + I_OUT + I_UP + I_DN;
        for (int it = gw; it < NITEMS; it += NGW) {
            int r = it;
            if (r < I_IN) { p0_transpose_item(a.in[12], DM, NIN, (bf16*)(ws + WS_WIN), true, scr, r, lane); continue; } r -= I_IN;
            if (r < I_OUT) { p0_transpose_item(a.in[18], DM, DM, (bf16*)(ws + WS_WOUT), false, scr, r, lane); continue; } r -= I_OUT;
            if (r < I_UP) { p0_transpose_item(a.in[19], DM, DFF, (bf16*)(ws + WS_WUP), false, scr, r, lane); continue; } r -= I_UP;
            p0_transpose_item(a.in[20], DFF, DM, (bf16*)(ws + WS_WDN), false, scr, r, lane);
        }
    }
    __syncthreads();
    {
        const float* w_ada = a.in[8]; const float* b_ada = a.in[9]; const float* c_p = a.in[6]; const float* c_s = a.in[7];
        float* ADA = (float*)(ws + WS_ADA);
        LAS bf16* Wt = (LAS bf16*)(lds + RING_OFF);
        constexpr int WST = 1032;
        for (int cb = bid; cb < NADA / 24; cb += G) {
            const int n0 = 24 * cb;
            for (int idx = tid; idx < 1024 * 6; idx += NWAVES * 64) { const int k = idx / 6, c4 = idx % 6;
                const f32x4 v = *(const f32x4*)(w_ada + (size_t)k * NADA + n0 + 4 * c4);
#pragma unroll
                for (int i = 0; i < 4; ++i) Wt[(4 * c4 + i) * WST + k] = (bf16)f2bf(v[i]); }
            for (int idx = tid; idx < 8 * 1024; idx += NWAVES * 64) Wt[(24 + (idx >> 10)) * WST + (idx & 1023)] = 0;
            __syncthreads();
            for (int rt = wave; rt < 9; rt += NWAVES) {
                const int row = 16 * rt + (lane & 15), rowc = row < NADAROW ? row : NADAROW - 1;
                const float* crow = rowc < 8 ? c_p + (size_t)rowc * DM : c_s + (size_t)(rowc - 8) * DM;
                f32x4 acc0 = {0.f, 0.f, 0.f, 0.f}, acc1 = {0.f, 0.f, 0.f, 0.f};
#pragma unroll 4
                for (int ks = 0; ks < 32; ++ks) {
                    const int k = 32 * ks + 8 * (lane >> 4);
                    const f32x4 a0 = *(const f32x4*)(crow + k), a1 = *(const f32x4*)(crow + k + 4);
                    v4u aw; aw.x = pk2(siluf(a0[0]), siluf(a0[1])); aw.y = pk2(siluf(a0[2]), siluf(a0[3])); aw.z = pk2(siluf(a1[0]), siluf(a1[1])); aw.w = pk2(siluf(a1[2]), siluf(a1[3]));
                    const bf16x8 A = __builtin_bit_cast(bf16x8, aw);
                    const bf16x8 B0 = *(const LAS bf16x8*)(Wt + (lane & 15) * WST + k), B1 = *(const LAS bf16x8*)(Wt + (16 + (lane & 15)) * WST + k);
                    acc0 = __builtin_amdgcn_mfma_f32_16x16x32_bf16(A, B0, acc0, 0, 0, 0);
                    acc1 = __builtin_amdgcn_mfma_f32_16x16x32_bf16(A, B1, acc1, 0, 0, 0);
                }
                const int n = lane & 15;
#pragma unroll
                for (int i = 0; i < 4; ++i) { const int r = 16 * rt + 4 * (lane >> 4) + i;
                    if (r < NADAROW) { ADA[(size_t)r * NADA + n0 + n] = acc0[i] + b_ada[n0 + n]; if (n < 8) ADA[(size_t)r * NADA + n0 + 16 + n] = acc1[i] + b_ada[n0 + 16 + n]; } }
            }
            __syncthreads();
        }
    }
}

template <int NR>
__device__ __forceinline__ void norm_mod_rows(const float* src_p, const float* src_s, const float* ADA, int sh_off, int sc_off, const float* gain, bf16* H, int lane, int m0, int mstride) {
    f32x4 v[NR][4], sc[NR][4], sh[NR][4], g[4];
#pragma unroll
    for (int r = 0; r < NR; ++r) { const int m = m0 + r * mstride;
        const float* xr; int ar;
        if (m < NP) { xr = src_p + (size_t)m * DM; ar = m >> 11; } else { xr = src_s + (size_t)(m - NP) * DM; ar = 8 + ((m - NP) >> 2); }
        const float* ap = ADA + (size_t)ar * NADA;
#pragma unroll
        for (int j = 0; j < 4; ++j) { const int c = 4 * (lane + 64 * j); v[r][j] = __builtin_nontemporal_load((const f32x4*)(xr + c)); sc[r][j] = *(const f32x4*)(ap + sc_off + c); sh[r][j] = *(const f32x4*)(ap + sh_off + c); } }
#pragma unroll
    for (int j = 0; j < 4; ++j) g[j] = *(const f32x4*)(gain + 4 * (lane + 64 * j));
#pragma unroll
    for (int r = 0; r < NR; ++r) { const int m = m0 + r * mstride;
        float s = 0.f;
#pragma unroll
        for (int j = 0; j < 4; ++j) s += (v[r][j].x * v[r][j].x + v[r][j].y * v[r][j].y) + (v[r][j].z * v[r][j].z + v[r][j].w * v[r][j].w);
        const float rstd = __builtin_amdgcn_rsqf(wave_sum(s) * (1.f / DM) + EPS);
        unsigned long long* o8 = (unsigned long long*)(H + (size_t)m * DM) + lane;
#pragma unroll
        for (int j = 0; j < 4; ++j) { const f32x4 y = v[r][j] * rstd * g[j] * (1.0f + sc[r][j]) + sh[r][j];
            o8[64 * j] = (unsigned long long)pk2(y.x, y.y) | ((unsigned long long)pk2(y.z, y.w) << 32); } }
}
__device__ __forceinline__ void norm_mod_phase(const float* src_p, const float* src_s, const float* ADA, int sh_off, int sc_off, const float* gain, bf16* H, int lane, int wave, int bid, int G) {
    const int gw = bid * NWAVES + wave, NGW = G * NWAVES;
    int m = gw;
    for (; m + 3 * NGW < MT; m += 4 * NGW) norm_mod_rows<4>(src_p, src_s, ADA, sh_off, sc_off, gain, H, lane, m, NGW);
    for (; m < MT; m += NGW) norm_mod_rows<1>(src_p, src_s, ADA, sh_off, sc_off, gain, H, lane, m, NGW);
}

constexpr int AT_KS = 144, AT_VS = 192;
constexpr int AT_K = 0, AT_V = 2 * 64 * AT_KS, AT_BYTES = AT_V + 2 * 64 * AT_VS;
__device__ __forceinline__ void attn_unit(const bf16* __restrict__ Qb, const bf16* __restrict__ Kb, const bf16* __restrict__ Vb, bf16* MIX, const float* sb_bias,
                                          LAS unsigned char* lds, int tid, int lane, int wave, int b, int h, int qb) {
    const int r32 = lane & 31, hi = lane >> 5, trel = 32 * wave + r32;
    const size_t mq = (size_t)b * SEQ + 256 * qb + trel;
    bf16x8 qr[4];
#pragma unroll
    for (int ds = 0; ds < 4; ++ds) qr[ds] = *(const bf16x8*)(Qb + mq * 512 + 64 * h + 16 * ds + 8 * hi);
    const float bias2 = sb_bias[h] * LOG2E;
    f32x16 o0, o1;
#pragma unroll
    for (int i = 0; i < 16; ++i) { o0[i] = 0.f; o1[i] = 0.f; }
    float R = 1.0f;
    const int NT = 4 * (qb + 1);
    const int skey = tid >> 3, sch = tid & 7;
    const bf16* kg = Kb + ((size_t)b * SEQ + skey) * 512 + 64 * h + 8 * sch;
    const bf16* vg = Vb + ((size_t)b * SEQ + skey) * 512 + 64 * h + 8 * sch;
    v4u kreg = *(const v4u*)(kg + (size_t)(NT - 1) * 64 * 512), vreg = *(const v4u*)(vg + (size_t)(NT - 1) * 64 * 512);
    const int kwr = skey * AT_KS + sch * 16, vwr = skey * AT_VS + sch * 16;
    const int krd = (32 * ((r32 >> 2) & 1) + (r32 & 3) + 4 * (r32 >> 3)) * AT_KS + 16 * hi;
    const int g16 = lane >> 4;
    const int vrd = (32 * (g16 >> 1) + ((lane & 15) >> 2)) * AT_VS + (16 * (g16 & 1) + 4 * (lane & 3)) * 2;
    int buf = 0;
    for (int jt = NT - 1; jt >= 0; --jt, buf ^= 1) {
        *(LAS v4u*)(lds + AT_K + buf * 64 * AT_KS + kwr) = kreg;
        *(LAS v4u*)(lds + AT_V + buf * 64 * AT_VS + vwr) = vreg;
        __syncthreads();
        if (jt > 0) { kreg = *(const v4u*)(kg + (size_t)(jt - 1) * 64 * 512); vreg = *(const v4u*)(vg + (size_t)(jt - 1) * 64 * 512); }
        const int jrel = jt - (NT - 4);
        if (jrel >= 0 && 2 * jrel > wave) continue;
        const LAS unsigned char* Kt = lds + AT_K + buf * 64 * AT_KS + krd;
        const LAS unsigned char* Vt = lds + AT_V + buf * 64 * AT_VS + vrd;
        f32x16 p0, p1;
#pragma unroll
        for (int i = 0; i < 16; ++i) { p0[i] = bias2; p1[i] = bias2; }
#pragma unroll
        for (int ds = 0; ds < 4; ++ds) {
            const bf16x8 a0 = *(const LAS bf16x8*)(Kt + 32 * ds), a1 = *(const LAS bf16x8*)(Kt + 16 * AT_KS + 32 * ds);
            p0 = __builtin_amdgcn_mfma_f32_32x32x16_bf16(a0, qr[ds], p0, 0, 0, 0);
            p1 = __builtin_amdgcn_mfma_f32_32x32x16_bf16(a1, qr[ds], p1, 0, 0, 0);
        }
        float e[32], r[32];
#pragma unroll
        for (int i = 0; i < 16; ++i) { e[i] = ex2(fminf(p0[i], 126.0f)); e[16 + i] = ex2(fminf(p1[i], 126.0f)); }
        if (jrel >= 0) {
            const int sb0 = 64 * jrel + 32 * hi;
#pragma unroll
            for (int i = 0; i < 32; ++i) e[i] = (sb0 + i < trel) ? e[i] : 0.0f;
        }
#pragma unroll
        for (int i = 0; i < 32; ++i) r[i] = rcpf_(1.0f + e[i]);
        float T;
        { float t8[8];
#pragma unroll
          for (int i = 0; i < 8; ++i) t8[i] = (r[4 * i] * r[4 * i + 1]) * (r[4 * i + 2] * r[4 * i + 3]);
          T = ((t8[0] * t8[1]) * (t8[2] * t8[3])) * ((t8[4] * t8[5]) * (t8[6] * t8[7])); }
        const float Tp = __shfl_xor(T, 32);
        float c = hi ? R : R * Tp;
#pragma unroll
        for (int i = 31; i >= 0; --i) { c *= r[i]; e[i] *= c; }
        R = R * T * Tp;
        bf16x8 pw[4];
#pragma unroll
        for (int j = 0; j < 4; ++j) { v4u w; w.x = pk2(e[8 * j], e[8 * j + 1]); w.y = pk2(e[8 * j + 2], e[8 * j + 3]); w.z = pk2(e[8 * j + 4], e[8 * j + 5]); w.w = pk2(e[8 * j + 6], e[8 * j + 7]); pw[j] = __builtin_bit_cast(bf16x8, w); }
#pragma unroll
        for (int j = 0; j < 4; ++j) {
            const bf16x8 v0 = cat8(vtr(Vt + j * 8 * AT_VS), vtr(Vt + j * 8 * AT_VS + 4 * AT_VS));
            const bf16x8 v1 = cat8(vtr(Vt + j * 8 * AT_VS + 64), vtr(Vt + j * 8 * AT_VS + 4 * AT_VS + 64));
            o0 = __builtin_amdgcn_mfma_f32_32x32x16_bf16(v0, pw[j], o0, 0, 0, 0);
            o1 = __builtin_amdgcn_mfma_f32_32x32x16_bf16(v1, pw[j], o1, 0, 0, 0);
        }
    }
    bf16* op = MIX + mq * DM + 64 * h + 4 * hi;
#pragma unroll
    for (int g4 = 0; g4 < 4; ++g4) {
        v2u w0, w1; w0.x = pk2(o0[4 * g4], o0[4 * g4 + 1]); w0.y = pk2(o0[4 * g4 + 2], o0[4 * g4 + 3]); w1.x = pk2(o1[4 * g4], o1[4 * g4 + 1]); w1.y = pk2(o1[4 * g4 + 2], o1[4 * g4 + 3]);
        *(v2u*)(op + 8 * g4) = w0; *(v2u*)(op + 32 + 8 * g4) = w1; }
    __syncthreads();
}

__device__ __forceinline__ float dec_qk(const f32x4 (&kv)[4], const f32x4 (&qv)[4], float bias2, bool newkeys, int lane, float& R) {
    float n4[4];
    const bool b0 = lane & 1, b1 = lane & 2, b2 = lane & 4, b3 = lane & 8;
#pragma unroll
    for (int i = 0; i < 4; ++i) {
        float v[4];
#pragma unroll
        for (int t = 0; t < 4; ++t) v[t] = (kv[i].x * qv[t].x + kv[i].y * qv[t].y) + (kv[i].z * qv[t].z + kv[i].w * qv[t].w);
        const float m0 = (b0 ? v[1] : v[0]) + __shfl_xor(b0 ? v[0] : v[1], 1), m1 = (b0 ? v[3] : v[2]) + __shfl_xor(b0 ? v[2] : v[3], 1);
        n4[i] = (b1 ? m1 : m0) + __shfl_xor(b1 ? m0 : m1, 2);
    }
    const float p0 = (b2 ? n4[1] : n4[0]) + __shfl_xor(b2 ? n4[0] : n4[1], 4), p1 = (b2 ? n4[3] : n4[2]) + __shfl_xor(b2 ? n4[2] : n4[3], 4);
    const float sc = (b3 ? p1 : p0) + __shfl_xor(b3 ? p0 : p1, 8);
    const int kappa = lane >> 2, t = lane & 3;
    float e = ex2(fminf(sc + bias2, 126.0f));
    if (newkeys) e = (kappa < t) ? e : 0.0f;
    const float r = rcpf_(1.0f + e);
    float x = r;
#pragma unroll
    for (int d = 4; d < 64; d <<= 1) { const float y = __shfl_down(x, d); x *= (lane + d < 64) ? y : 1.0f; }
    const float xs = __shfl_down(x, 4);
    const float excl = (lane + 4 < 64) ? xs : 1.0f;
    const float tot = __shfl(x, t);
    const float w = e * r * excl * R;
    R *= tot;
    return w;
}
__device__ __forceinline__ void dec_pv(const f32x4 (&vv)[4], float w, int lane, f32x4 (&o)[4]) {
#pragma unroll
    for (int i = 0; i < 4; ++i)
#pragma unroll
        for (int tt = 0; tt < 4; ++tt) { const float wb = __shfl(w, (lane & 48) + 4 * i + tt); o[tt] += wb * vv[i]; }
}
__device__ __forceinline__ void dec_hgrn_item(const Args& a, int item, int lane);
__device__ __forceinline__ void dec_seq_item(const Args& a, int sb, int lane, int wave) {
    const int h = wave, g = lane >> 4, c = lane & 15;
    const bf16* Qb = (const bf16*)(a.ws + WS_Q);
    const float* ck = a.in[2]; const float* cv = a.in[3]; const int* pt = (const int*)a.in[5] + sb * NPAGE;
    const float bias2 = a.in[15][h] * LOG2E;
    f32x4 qv[4];
#pragma unroll
    for (int t = 0; t < 4; ++t) { const v2u w = *(const v2u*)(Qb + (size_t)(NP + 4 * sb + t) * 512 + 64 * h + 4 * c); qv[t] = (f32x4){bflo(w.x), bfhi(w.x), bflo(w.y), bfhi(w.y)}; }
    f32x4 o[4];
#pragma unroll
    for (int t = 0; t < 4; ++t) o[t] = (f32x4){0.f, 0.f, 0.f, 0.f};
    float R = 1.0f;
    const size_t lane_off = (size_t)(4 * g) * 512 + 64 * h + 4 * c;
    const int pgv = pt[lane & 15];
    f32x4 ka[4], va[4], kb[4], vb[4], kc[4], vc[4];
#pragma unroll
    for (int i = 0; i < 4; ++i) { ka[i] = (f32x4){0.f, 0.f, 0.f, 0.f}; va[i] = ka[i]; kb[i] = ka[i]; vb[i] = ka[i]; kc[i] = ka[i]; vc[i] = ka[i]; }
#define DEC_ADDR(s) (((size_t)__builtin_amdgcn_readlane(pgv, 15 - ((s) >> 3)) * PAGE + 16 * (7 - ((s) & 7))) * 512 + lane_off)
#define DEC_LOAD(XX, base, s) do { const float* p_ = (base) + DEC_ADDR(s); const float* p2_ = p_ + 1024; \
        asm volatile("global_load_dwordx4 %0, %4, off nt\n\tglobal_load_dwordx4 %1, %4, off offset:2048 nt\n\tglobal_load_dwordx4 %2, %5, off nt\n\tglobal_load_dwordx4 %3, %5, off offset:2048 nt" \
                     : "+v"(XX[0]), "+v"(XX[1]), "+v"(XX[2]), "+v"(XX[3]) : "v"(p_), "v"(p2_) : "memory"); } while (0)
#define DEC_WAIT(XX, N) asm volatile("s_waitcnt vmcnt(" #N ")" : "+v"(XX[0]), "+v"(XX[1]), "+v"(XX[2]), "+v"(XX[3]) :: "memory")
    {
        const float* kp = a.out + O_KS + (size_t)(4 * sb) * 512 + 64 * h + 4 * c; const float* vp = a.out + O_VS + (size_t)(4 * sb) * 512 + 64 * h + 4 * c;
        f32x4 kn[4], vn[4];
#pragma unroll
        for (int i = 0; i < 4; ++i) { const int kk = (g == 0) ? i : 0; kn[i] = *(const f32x4*)(kp + kk * 512); vn[i] = *(const f32x4*)(vp + kk * 512); }
        const float w = dec_qk(kn, qv, bias2, true, lane, R);
        dec_pv(vn, w, lane, o);
        asm volatile("s_waitcnt vmcnt(0)" ::: "memory");
    }
    DEC_LOAD(ka, ck, 0); DEC_LOAD(va, cv, 0); DEC_LOAD(kb, ck, 1); DEC_LOAD(vb, cv, 1); DEC_LOAD(kc, ck, 2); DEC_LOAD(vc, cv, 2);
#define SB() __builtin_amdgcn_sched_barrier(0)
#define DEC_STAGE(KK, VV, sn) { SB(); DEC_WAIT(KK, 20); const float w = dec_qk(KK, qv, bias2, false, lane, R); SB(); DEC_LOAD(KK, ck, sn); SB(); DEC_WAIT(VV, 20); dec_pv(VV, w, lane, o); SB(); DEC_LOAD(VV, cv, sn); SB(); }
#pragma unroll 1
    for (int s = 0; s < 126; s += 3) {
        const int s3 = s + 3;
        DEC_STAGE(ka, va, s3) DEC_STAGE(kb, vb, s3 + 1) DEC_STAGE(kc, vc, (s3 + 2 < 128 ? s3 + 2 : 127))
    }
    DEC_STAGE(ka, va, 127) DEC_STAGE(kb, vb, 127)
#undef DEC_STAGE
    asm volatile("s_waitcnt vmcnt(0)" : "+v"(ka[0]), "+v"(ka[1]), "+v"(ka[2]), "+v"(ka[3]), "+v"(va[0]), "+v"(va[1]), "+v"(va[2]), "+v"(va[3]) :: "memory");
    asm volatile("s_waitcnt vmcnt(0)" : "+v"(kb[0]), "+v"(kb[1]), "+v"(kb[2]), "+v"(kb[3]), "+v"(vb[0]), "+v"(vb[1]), "+v"(vb[2]), "+v"(vb[3]) :: "memory");
    asm volatile("s_waitcnt vmcnt(0)" : "+v"(kc[0]), "+v"(kc[1]), "+v"(kc[2]), "+v"(kc[3]), "+v"(vc[0]), "+v"(vc[1]), "+v"(vc[2]), "+v"(vc[3]) :: "memory");
#undef SB
#undef DEC_WAIT
#undef DEC_ADDR
#undef DEC_LOAD
#pragma unroll
    for (int t = 0; t < 4; ++t)
#pragma unroll
        for (int d = 0; d < 4; ++d) { float x = o[t][d]; x += __shfl_xor(x, 16); x += __shfl_xor(x, 32); o[t][d] = x; }
    int lane2 = lane; asm volatile("" : "+v"(lane2));
    bf16* MIX = (bf16*)(a.ws + WS_MIX);
    if ((lane2 >> 4) == 0) {
#pragma unroll
        for (int t = 0; t < 4; ++t) { v2u w; w.x = pk2(o[t].x, o[t].y); w.y = pk2(o[t].z, o[t].w); *(v2u*)(MIX + (size_t)(NP + 4 * sb + t) * DM + 64 * h + 4 * (lane2 & 15)) = w; } }
    dec_hgrn_item(a, sb * 8 + h, lane2);
}

__device__ __forceinline__ void dec_hgrn_item(const Args& a, int item, int lane) {
    const int sb = item >> 3, h = item & 7;
    const float* LF = (const float*)(a.ws + WS_LF); const bf16* HQ = (const bf16*)(a.ws + WS_HQ); const bf16* HV = (const bf16*)(a.ws + WS_HV); const bf16* HG = (const bf16*)(a.ws + WS_HG);
    bf16* MIX = (bf16*)(a.ws + WS_MIX);
    const float* s0 = a.in[4] + (size_t)(sb * 8 + h) * 4096;
    float S[64];
#pragma unroll
    for (int k = 0; k < 64; ++k) S[k] = s0[k * 64 + lane];
    const float gain = a.in[17][lane];
#pragma unroll 1
    for (int t = 0; t < 4; ++t) {
        const size_t m = (size_t)NP + 4 * sb + t;
        const float lf = LF[m * 512 + 64 * h + lane];
        const float f = ex2(lf * LOG2E), kk = 1.0f - f, q = bf2f(HQ[m * 512 + 64 * h + lane]), vt = bf2f(HV[m * 512 + 64 * h + lane]), gt = bf2f(HG[m * 512 + 64 * h + lane]);
        float o = 0.f;
#pragma unroll
        for (int k = 0; k < 64; ++k) {
            const float fk = __builtin_bit_cast(float, __builtin_amdgcn_readlane(__builtin_bit_cast(int, f), k));
            const float kv = __builtin_bit_cast(float, __builtin_amdgcn_readlane(__builtin_bit_cast(int, kk), k));
            const float qk = __builtin_bit_cast(float, __builtin_amdgcn_readlane(__builtin_bit_cast(int, q), k));
            S[k] = fk * S[k] + kv * vt; o += S[k] * qk; }
        const float ss = wave_sum(o * o);
        const float y = o * __builtin_amdgcn_rsqf(ss * (1.0f / 64.0f) + EPS) * gain * gt;
        MIX[m * DM + 512 + 64 * h + lane] = (bf16)f2bf(y);
    }
    float* so = a.out + O_SS + (size_t)(sb * 8 + h) * 4096;
#pragma unroll
    for (int k = 0; k < 64; ++k) so[k * 64 + lane] = S[k];
}

constexpr int HG_SEG = 0, HG_DEC = 2048, HG_QD = 4096, HG_ROW = 144, HG_KD = HG_QD + 64 * HG_ROW, HG_KET = HG_KD + 64 * HG_ROW, HG_V = HG_KET + 64 * HG_ROW, HG_VS = 192,
              HG_OB = HG_V + 64 * HG_VS, HG_OBS = 272, HG_BYTES = HG_OB + 64 * HG_OBS;
__device__ __forceinline__ void hgrn_chain(const Args& a, LAS unsigned char* lds, int tid, int lane, int wave, int b, int h) {
    const float* LF = (const float*)(a.ws + WS_LF); const bf16* HQ = (const bf16*)(a.ws + WS_HQ); const bf16* HV = (const bf16*)(a.ws + WS_HV); const bf16* HG = (const bf16*)(a.ws + WS_HG);
    bf16* MIX = (bf16*)(a.ws + WS_MIX);
    const int k = lane, seg = wave;
    const int tB = tid >> 3, c8 = tid & 7;
    const int r32 = lane & 31, hi = lane >> 5, tb = (wave >> 1) & 1, vb = wave & 1, g16 = lane >> 4;
    f32x16 S0, S1;
#pragma unroll
    for (int i = 0; i < 16; ++i) { S0[i] = 0.f; S1[i] = 0.f; }
    float lfr[8]; unsigned short qh[8]; v4u vld, gld;
#define HG_LOAD(n) do { const size_t m0_ = (size_t)b * SEQ + 64 * (n); \
        _Pragma("unroll") for (int j = 0; j < 8; ++j) { lfr[j] = LF[(m0_ + 8 * seg + j) * 512 + 64 * h + k]; qh[j] = HQ[(m0_ + 8 * seg + j) * 512 + 64 * h + k]; } \
        vld = *(const v4u*)(HV + (m0_ + tB) * 512 + 64 * h + 8 * c8); gld = *(const v4u*)(HG + (m0_ + tB) * 512 + 64 * h + 8 * c8); } while (0)
    HG_LOAD(0);
    LAS float* SEG = (LAS float*)(lds + HG_SEG); LAS float* DEC = (LAS float*)(lds + HG_DEC);
    const f32x4 gn0 = *(const f32x4*)(a.in[17] + 8 * c8), gn1 = *(const f32x4*)(a.in[17] + 8 * c8 + 4);
    const int krd = (32 * ((r32 >> 2) & 1) + (r32 & 3) + 4 * (r32 >> 3)) * HG_ROW + 16 * hi;
    const int vrd_l = (32 * (g16 >> 1) + ((lane & 15) >> 2)) * HG_VS + (32 * vb + 16 * (g16 & 1) + 4 * (lane & 3)) * 2;
    const int vrd_n = (8 * (g16 >> 1) + ((lane & 15) >> 2)) * HG_VS + (32 * vb + 16 * (g16 & 1) + 4 * (lane & 3)) * 2;
#pragma unroll 1
    for (int n = 0; n < SEQ / 64; ++n) {
        const size_t m0 = (size_t)b * SEQ + 64 * n;
        float cum[8];
        { float s = 0.f;
#pragma unroll
          for (int j = 0; j < 8; ++j) { s += lfr[j]; cum[j] = s; } }
        SEG[seg * 64 + k] = cum[7];
        __syncthreads();
        float prefix = 0.f, btot = 0.f;
#pragma unroll
        for (int s = 0; s < 8; ++s) { const float x = SEG[s * 64 + k]; btot += x; prefix += (s < seg) ? x : 0.f; }
        { unsigned kep[4];
#pragma unroll
          for (int j = 0; j < 8; j += 2) {
              float ke2[2];
#pragma unroll
              for (int u = 0; u < 2; ++u) { const int jj = j + u; const float bb = prefix + cum[jj], f = ex2(lfr[jj] * LOG2E), kk = 1.0f - f;
                  const float qd = bf2f(qh[jj]) * ex2(bb * LOG2E), kd = kk * ex2(-bb * LOG2E); ke2[u] = kk * ex2((btot - bb) * LOG2E);
                  *(LAS bf16*)(lds + HG_QD + (8 * seg + jj) * HG_ROW + 2 * k) = (bf16)f2bf(qd);
                  *(LAS bf16*)(lds + HG_KD + (8 * seg + jj) * HG_ROW + 2 * k) = (bf16)f2bf(kd); }
              kep[j >> 1] = pk2(ke2[0], ke2[1]); }
          *(LAS v4u*)(lds + HG_KET + k * HG_ROW + 16 * seg) = (v4u){kep[0], kep[1], kep[2], kep[3]}; }
        if (seg == 0) DEC[k] = ex2(btot * LOG2E);
        *(LAS v4u*)(lds + HG_V + tB * HG_VS + 16 * c8) = vld;
        const v4u gcur = gld;
        __syncthreads();
        if (n + 1 < SEQ / 64) HG_LOAD(n + 1);
        if (wave < 4) {
            f32x16 p0, p1;
#pragma unroll
            for (int i = 0; i < 16; ++i) { p0[i] = 0.f; p1[i] = 0.f; }
#pragma unroll
            for (int ks = 0; ks < 4; ++ks) {
                const bf16x8 a0 = *(const LAS bf16x8*)(lds + HG_KD + krd + 32 * ks), a1 = *(const LAS bf16x8*)(lds + HG_KD + krd + 16 * HG_ROW + 32 * ks);
                const bf16x8 bq = *(const LAS bf16x8*)(lds + HG_QD + (32 * tb + r32) * HG_ROW + 32 * ks + 16 * hi);
                p0 = __builtin_amdgcn_mfma_f32_32x32x16_bf16(a0, bq, p0, 0, 0, 0);
                p1 = __builtin_amdgcn_mfma_f32_32x32x16_bf16(a1, bq, p1, 0, 0, 0);
            }
            const int tq = 32 * tb + r32;
            float e[32];
#pragma unroll
            for (int i = 0; i < 16; ++i) { e[i] = (32 * hi + i <= tq) ? p0[i] : 0.f; e[16 + i] = (32 * hi + 16 + i <= tq) ? p1[i] : 0.f; }
            bf16x8 pw[4];
#pragma unroll
            for (int j = 0; j < 4; ++j) { v4u w; w.x = pk2(e[8 * j], e[8 * j + 1]); w.y = pk2(e[8 * j + 2], e[8 * j + 3]); w.z = pk2(e[8 * j + 4], e[8 * j + 5]); w.w = pk2(e[8 * j + 6], e[8 * j + 7]); pw[j] = __builtin_bit_cast(bf16x8, w); }
            f32x16 o;
#pragma unroll
            for (int i = 0; i < 16; ++i) o[i] = 0.f;
#pragma unroll
            for (int kb = 0; kb < 2; ++kb)
#pragma unroll
                for (int s2 = 0; s2 < 2; ++s2) {
                    const f32x16& Sx = kb ? S1 : S0;
                    v4u aw; aw.x = pk2(Sx[8 * s2], Sx[8 * s2 + 1]); aw.y = pk2(Sx[8 * s2 + 2], Sx[8 * s2 + 3]); aw.z = pk2(Sx[8 * s2 + 4], Sx[8 * s2 + 5]); aw.w = pk2(Sx[8 * s2 + 6], Sx[8 * s2 + 7]);
                    const LAS unsigned char* qp = lds + HG_QD + (32 * tb + r32) * HG_ROW + (32 * kb + 16 * s2 + 4 * hi) * 2;
                    const v2u q0 = *(const LAS v2u*)qp, q1 = *(const LAS v2u*)(qp + 16);
                    const v4u bw = (v4u){q0.x, q0.y, q1.x, q1.y};
                    o = __builtin_amdgcn_mfma_f32_32x32x16_bf16(__builtin_bit_cast(bf16x8, aw), __builtin_bit_cast(bf16x8, bw), o, 0, 0, 0);
                }
#pragma unroll
            for (int j = 0; j < 4; ++j) {
                const bf16x8 vf = cat8(vtr(lds + HG_V + vrd_l + j * 8 * HG_VS), vtr(lds + HG_V + vrd_l + j * 8 * HG_VS + 4 * HG_VS));
                o = __builtin_amdgcn_mfma_f32_32x32x16_bf16(vf, pw[j], o, 0, 0, 0);
            }
#pragma unroll
            for (int g4 = 0; g4 < 4; ++g4) *(LAS f32x4*)(lds + HG_OB + tq * HG_OBS + (32 * vb + 8 * g4 + 4 * hi) * 4) = (f32x4){o[4 * g4], o[4 * g4 + 1], o[4 * g4 + 2], o[4 * g4 + 3]};
#pragma unroll
            for (int g4 = 0; g4 < 4; ++g4) { const f32x4 d0 = *(const LAS f32x4*)(DEC + 8 * g4 + 4 * hi), d1 = *(const LAS f32x4*)(DEC + 32 + 8 * g4 + 4 * hi);
#pragma unroll
                for (int i = 0; i < 4; ++i) { S0[4 * g4 + i] *= d0[i]; S1[4 * g4 + i] *= d1[i]; } }
#pragma unroll
            for (int ts = 0; ts < 4; ++ts) {
                const bf16x8 vf = cat8(vtr(lds + HG_V + vrd_n + ts * 16 * HG_VS), vtr(lds + HG_V + vrd_n + ts * 16 * HG_VS + 4 * HG_VS));
                const bf16x8 k0 = *(const LAS bf16x8*)(lds + HG_KET + r32 * HG_ROW + 32 * ts + 16 * hi), k1 = *(const LAS bf16x8*)(lds + HG_KET + (32 + r32) * HG_ROW + 32 * ts + 16 * hi);
                S0 = __builtin_amdgcn_mfma_f32_32x32x16_bf16(k0, vf, S0, 0, 0, 0);
                S1 = __builtin_amdgcn_mfma_f32_32x32x16_bf16(k1, vf, S1, 0, 0, 0);
            }
        }
        __syncthreads();
        {
            const f32x4 x0 = *(const LAS f32x4*)(lds + HG_OB + tB * HG_OBS + 32 * c8), x1 = *(const LAS f32x4*)(lds + HG_OB + tB * HG_OBS + 32 * c8 + 16);
            float ss = (x0.x * x0.x + x0.y * x0.y) + (x0.z * x0.z + x0.w * x0.w) + (x1.x * x1.x + x1.y * x1.y) + (x1.z * x1.z + x1.w * x1.w);
            ss += __shfl_xor(ss, 1); ss += __shfl_xor(ss, 2); ss += __shfl_xor(ss, 4);
            const float rstd = __builtin_amdgcn_rsqf(ss * (1.0f / 64.0f) + EPS);
            const f32x4 g0 = (f32x4){bflo(gcur.x), bfhi(gcur.x), bflo(gcur.y), bfhi(gcur.y)}, g1 = (f32x4){bflo(gcur.z), bfhi(gcur.z), bflo(gcur.w), bfhi(gcur.w)};
            const f32x4 y0 = x0 * rstd * gn0 * g0, y1 = x1 * rstd * gn1 * g1;
            *(v4u*)(MIX + (m0 + tB) * DM + 512 + 64 * h + 8 * c8) = pg8::pack8(y0, y1);
        }
    }
#undef HG_LOAD
    if (wave < 2) {
        float* so = a.out + O_SP + (size_t)(b * 8 + h) * 4096 + 32 * vb + r32;
#pragma unroll
        for (int r = 0; r < 16; ++r) { const int kr = (r & 3) + 8 * (r >> 2) + 4 * hi; so[(size_t)kr * 64] = S0[r]; so[(size_t)(32 + kr) * 64] = S1[r]; }
    }
    __syncthreads();
}


template <int NCB, int KSPLIT, class Epi>
__device__ __forceinline__ void skinny_gemm(const bf16* __restrict__ As, const bf16* __restrict__ Bt, int N, int K, const Epi& E, LAS unsigned char* lds, int tid, int lane, int wave, int bid, int G) {
    static_assert(NCB * KSPLIT == 4, "8 waves = 2 row halves x NCB column blocks x KSPLIT K slices");
    constexpr int RWG = 64 + 32 * NCB, RW = KSPLIT * RWG, ROWB = 144, BUFB = RW * ROWB, NLD = RW * 8 / 512, REDOFF = 0;
    static_assert(RW * 8 % 512 == 0 && 2 * BUFB <= RING_BYTES, "skinny stage geometry");
    const int r32 = lane & 31, hi = lane >> 5;
    const int ntile = 8 * (N / (32 * NCB));
    const int rh = wave & 1, rest = wave >> 1, cb = rest % NCB, ks = rest / NCB;
    const int kl = K / KSPLIT, nst = kl / 64;
    for (int tile = bid; tile < ntile; tile += G) {
        const int rt = tile & 7, ct = tile >> 3;
        const bf16* src[NLD]; int dst[NLD];
#pragma unroll
        for (int j = 0; j < NLD; ++j) { const int idx = tid + 512 * j, rho = idx >> 3, c16 = idx & 7, q = rho / RWG, w = rho % RWG;
            src[j] = (w < 64 ? As + (size_t)(64 * rt + w) * K : Bt + (size_t)(32 * NCB * ct + (w - 64)) * K) + q * kl + 8 * c16;
            dst[j] = rho * ROWB + 16 * c16; }
        v4u st[NLD];
#pragma unroll
        for (int j = 0; j < NLD; ++j) st[j] = *(const v4u*)(src[j]);
        f32x16 acc;
#pragma unroll
        for (int i = 0; i < 16; ++i) acc[i] = 0.f;
        const int brd = (ks * RWG + 32 * rh + r32) * ROWB + 16 * hi, ard = (ks * RWG + 64 + 32 * cb + r32) * ROWB + 16 * hi;
        for (int s = 0; s < nst; ++s) {
            const int buf = (s & 1) * BUFB;
#pragma unroll
            for (int j = 0; j < NLD; ++j) *(LAS v4u*)(lds + buf + dst[j]) = st[j];
            __syncthreads();
            if (s + 1 < nst) {
#pragma unroll
                for (int j = 0; j < NLD; ++j) st[j] = *(const v4u*)(src[j] + 64 * (s + 1)); }
#pragma unroll
            for (int u = 0; u < 4; ++u) {
                const bf16x8 a = *(const LAS bf16x8*)(lds + buf + ard + 32 * u), b = *(const LAS bf16x8*)(lds + buf + brd + 32 * u);
                acc = __builtin_amdgcn_mfma_f32_32x32x16_bf16(a, b, acc, 0, 0, 0); }
        }
        if (KSPLIT > 1) {
            LAS float* red = (LAS float*)(lds + REDOFF);
            __syncthreads();
            if (ks > 0) {
#pragma unroll
                for (int r = 0; r < 16; ++r) red[(((ks - 1) * 2 + rh) * 16 + r) * 64 + lane] = acc[r]; }
            __syncthreads();
            if (ks == 0) {
#pragma unroll
                for (int p = 0; p < KSPLIT - 1; ++p)
#pragma unroll
                    for (int r = 0; r < 16; ++r) acc[r] += red[((p * 2 + rh) * 16 + r) * 64 + lane]; }
        }
        if (ks == 0) E(acc, 64 * rt + 32 * rh + r32, 32 * (NCB * ct + cb), hi);
        __syncthreads();
    }
}
struct SkEpiResGate {
    const float* base; float* out; const float* ada; int goff;
    __device__ __forceinline__ void operator()(const f32x16& acc, int srow, int n0, int hi) const {
        const float* gp = ada + (size_t)(8 + (srow >> 2)) * NADA + goff;
#pragma unroll
        for (int g4 = 0; g4 < 4; ++g4) { const int c = n0 + 8 * g4 + 4 * hi; const f32x4 x = *(const f32x4*)(base + (size_t)srow * DM + c), g = *(const f32x4*)(gp + c);
            *(f32x4*)(out + (size_t)srow * DM + c) = x + g * (f32x4){acc[4 * g4], acc[4 * g4 + 1], acc[4 * g4 + 2], acc[4 * g4 + 3]}; }
    }
};
struct SkEpiRelu2 {
    bf16* O; int ldc;
    __device__ __forceinline__ void operator()(const f32x16& acc, int srow, int n0, int hi) const {
#pragma unroll
        for (int g4 = 0; g4 < 4; ++g4) { float v[4];
#pragma unroll
            for (int i = 0; i < 4; ++i) { const float x = fmaxf(acc[4 * g4 + i], 0.f); v[i] = x * x; }
            v2u w; w.x = pk2(v[0], v[1]); w.y = pk2(v[2], v[3]); *(v2u*)(O + (size_t)srow * ldc + n0 + 8 * g4 + 4 * hi) = w; }
    }
};

__global__ void __launch_bounds__(NWAVES * 64, 2) hymba_fwd(Args args) {
    extern __shared__ __attribute__((aligned(16))) unsigned char lds_raw[];
    LAS unsigned char* lds = (LAS unsigned char*)lds_raw;
    volatile LAS unsigned* MISC = (volatile LAS unsigned*)(lds + MISC_OFF);
    const int tid0 = threadIdx.x;
    const int G = gridDim.x, bid = blockIdx.x;
    unsigned char* ws = args.ws;
    gu32* ctl = (gu32*)(ws + WS_CTL);
    for (int u = tid0; u < (LDS_BYTES - LDSCTL_OFF) / 4; u += NWAVES * 64) ((LAS unsigned*)(lds + LDSCTL_OFF))[u] = 0u;
    __syncthreads();
    XcdBarrier bar; bar.bar = (unsigned*)(ctl + CW_BAR); bar.x = 0; bar.st = nullptr;
    if (N_LAUNCHES == 1) bar = xcd_barrier_post((unsigned*)(ctl + CW_BAR), MISC + 8);
#define GRID_BAR() do { if (N_LAUNCHES == 1) xcd_barrier(bar); } while (0)
    const int lo = args.ph_lo, hi = args.ph_hi;
#define IN(k) (lo <= (k) && (k) < hi)
#define PHASE_IDS() int tid = tid0; asm volatile("" : "+v"(tid)); const int lane = tid & 63, wave = __builtin_amdgcn_readfirstlane(tid >> 6); (void)lane; (void)wave
    bf16* H = (bf16*)(ws + WS_H); float* ADA = (float*)(ws + WS_ADA); bf16* MIX = (bf16*)(ws + WS_MIX);

    if (IN(0)) { PHASE_IDS(); p0_prologue(args, lds, tid, lane, wave, bid, G); GRID_BAR(); }
    if (IN(1)) { PHASE_IDS(); norm_mod_phase(args.in[0], args.in[1], ADA, 0, 1024, args.in[10], H, lane, wave, bid, G); GRID_BAR(); }
    if (IN(2)) { PHASE_IDS();
        pg8::Gemm g{H, (const bf16*)(ws + WS_WIN), MT, NIN, DM}; pg8::StaticOrder S; S.init(MT, NIN, G, bid);
        pg8::EpiInProj E{(bf16*)(ws + WS_Q), (bf16*)(ws + WS_K), (bf16*)(ws + WS_V), (bf16*)(ws + WS_HQ), (bf16*)(ws + WS_HV), (bf16*)(ws + WS_HG), (float*)(ws + WS_LF), args.out, args.in[13], args.in[14], args.in[16]};
        pg8::gemm_phase<pg8::EpiInProj, pg8::StaticOrder, true, true>(lds + RING_OFF, g, S, E);
        GRID_BAR();
    }
    if (IN(3)) { PHASE_IDS();
#define POP(qi) ({ if (tid == 0) MISC[16] = __hip_atomic_fetch_add(ctl + CW_Q + 64 * (qi), 1u, RLX_AGENT); __syncthreads(); const int it_ = (int)MISC[16]; __syncthreads(); it_; })
#define LAUNDER() int tid_ = tid; asm volatile("" : "+v"(tid_)); const int lane_ = tid_ & 63, wave_ = __builtin_amdgcn_readfirstlane(tid_ >> 6)
        { LAUNDER(); for (;;) { const int it = POP(0); if (it >= 128) break; dec_seq_item(args, it, lane_, wave_); } }
        { LAUNDER(); for (;;) { const int it = POP(1); if (it >= 64) break; hgrn_chain(args, lds, tid_, lane_, wave_, it >> 3, it & 7); } }
        { LAUNDER(); for (;;) { const int u = POP(2); if (u >= 512) break; const int bh = u & 63;
            attn_unit((const bf16*)(ws + WS_Q), (const bf16*)(ws + WS_K), (const bf16*)(ws + WS_V), MIX, args.in[15], lds, tid_, lane_, wave_, bh >> 3, bh & 7, 7 - (u >> 6)); } }
#undef LAUNDER
#undef POP
        GRID_BAR();
    }
    if (IN(4)) { }
    if (IN(5)) { PHASE_IDS();
        { SkEpiResGate Es{args.in[1], args.out + (size_t)NP * DM, ADA, 2048};
          skinny_gemm<1, 4, SkEpiResGate>(MIX + (size_t)NP * DM, (const bf16*)(ws + WS_WOUT), DM, DM, Es, lds, tid, lane, wave, bid, G); }
        pg8::Gemm g{MIX, (const bf16*)(ws + WS_WOUT), NP, DM, DM}; pg8::StaticOrder S; S.init(NP, DM, G, bid);
        pg8::EpiResGate E{args.in[0], args.in[1], args.out, ADA, 2048};
        pg8::gemm_phase<pg8::EpiResGate, pg8::StaticOrder, true, true>(lds + RING_OFF, g, S, E);
        GRID_BAR();
    }
    if (IN(6)) { PHASE_IDS(); norm_mod_phase(args.out, args.out + (size_t)NP * DM, ADA, 3072, 4096, args.in[11], H, lane, wave, bid, G); GRID_BAR(); }
    if (IN(7)) { PHASE_IDS();
        { SkEpiRelu2 Es{(bf16*)(ws + WS_HUP) + (size_t)NP * DFF, DFF};
          skinny_gemm<4, 1, SkEpiRelu2>(H + (size_t)NP * DM, (const bf16*)(ws + WS_WUP), DFF, DM, Es, lds, tid, lane, wave, bid, G); }
        pg8::Gemm g{H, (const bf16*)(ws + WS_WUP), NP, DFF, DM}; pg8::StaticOrder S; S.init(NP, DFF, G, bid);
        pg8::EpiRelu2 E{(bf16*)(ws + WS_HUP), DFF};
        pg8::gemm_phase<pg8::EpiRelu2, pg8::StaticOrder, true, true>(lds + RING_OFF, g, S, E);
        GRID_BAR();
    }
    if (IN(8)) { PHASE_IDS();
        { SkEpiResGate Es{args.out + (size_t)NP * DM, args.out + (size_t)NP * DM, ADA, 5120};
          skinny_gemm<1, 4, SkEpiResGate>((const bf16*)(ws + WS_HUP) + (size_t)NP * DFF, (const bf16*)(ws + WS_WDN), DM, DFF, Es, lds, tid, lane, wave, bid, G); }
        pg8::Gemm g{(const bf16*)(ws + WS_HUP), (const bf16*)(ws + WS_WDN), NP, DM, DFF}; pg8::StaticOrder S; S.init(NP, DM, G, bid);
        pg8::EpiResGate E{args.out, args.out + (size_t)NP * DM, args.out, ADA, 5120};
        pg8::gemm_phase<pg8::EpiResGate, pg8::StaticOrder, true, true>(lds + RING_OFF, g, S, E);
    }
#undef IN
#undef GRID_BAR
}

extern "C" void kernel_launch(void* const* d_in, const int* in_sizes, int n_in, void* d_out, int out_size, void* d_ws, size_t ws_size, hipStream_t stream) {
    static int grid = 0;
    if (grid == 0) {
        if (n_in != 21 || in_sizes[0] != NP * DM || out_size != (int)O_END || ws_size < WS_END) { fprintf(stderr, "kernel_launch: unexpected shapes (n_in %d, in0 %d, out %d, ws %zu); nothing launched\n", n_in, n_in > 0 ? in_sizes[0] : -1, out_size, ws_size); grid = -1; return; }
        int dev = 0, cus = 0, per_cu = 0;
        if (hipGetDevice(&dev) != hipSuccess || hipDeviceGetAttribute(&cus, hipDeviceAttributeMultiprocessorCount, dev) != hipSuccess) { fprintf(stderr, "kernel_launch: device query failed\n"); grid = -1; return; }
        if (hipFuncSetAttribute((const void*)hymba_fwd, hipFuncAttributeMaxDynamicSharedMemorySize, LDS_BYTES) != hipSuccess) { fprintf(stderr, "kernel_launch: hipFuncSetAttribute failed\n"); grid = -1; return; }
        if (hipOccupancyMaxActiveBlocksPerMultiprocessor(&per_cu, (const void*)hymba_fwd, NWAVES * 64, LDS_BYTES) != hipSuccess || per_cu < 1)
            fprintf(stderr, "kernel_launch: note: occupancy query reports %d workgroups per CU\n", per_cu);
        (void)hipGetLastError();
        grid = cus;
    }
    if (grid < 0) return;
    if (hipMemsetAsync((char*)d_ws + WS_CTL, 0, CTL_ZERO_BYTES, stream) != hipSuccess) { fprintf(stderr, "kernel_launch: memset failed\n"); return; }
    Args a{};
    for (int i = 0; i < 21; ++i) a.in[i] = (const float*)d_in[i];
    a.out = (float*)d_out; a.ws = (unsigned char*)d_ws;
    if (N_LAUNCHES == 1) { a.ph_lo = 0; a.ph_hi = NPHASE; hipLaunchKernelGGL(hymba_fwd, dim3(grid), dim3(NWAVES * 64), LDS_BYTES, stream, a); }
    else for (int li = 0; li < NPHASE; ++li) { a.ph_lo = li; a.ph_hi = li + 1; hipLaunchKernelGGL(hymba_fwd, dim3(grid), dim3(NWAVES * 64), LDS_BYTES, stream, a); }
    const hipError_t le = hipPeekAtLastError();
    if (le != hipSuccess) fprintf(stderr, "kernel_launch: launch failed: %s\n", hipGetErrorName(le));
}
```

```cpp
#include <hip/hip_runtime.h>
#include <cstdio>
#include <cstdint>
namespace cfg {
constexpr int DM = 1024, NP = 16384, NS = 512, MT = NP + NS, NIN = 3584, DFF = 4096, NADA = 6144, NADAROW = 136;
constexpr int SEQ = 2048, DB = 128, DSQ = 4, PAST = 2048, PAGE = 128, NPAGE = 16;
constexpr float EPS = 1e-6f;
constexpr float LOG2E = 1.4426950408889634f;
constexpr float QSCALE = 0.125f * LOG2E;
constexpr size_t O_Y = 0, O_KP = 17301504, O_VP = 25690112, O_KS = 34078720, O_VS = 34340864, O_SP = 34603008, O_SS = 34865152, O_END = 39059456;
}
namespace pg8 {
#define PG8_LAS __attribute__((address_space(3)))
typedef unsigned short bf16_t;
typedef short bf16x8 __attribute__((ext_vector_type(8)));
typedef float f32x4 __attribute__((ext_vector_type(4)));
typedef unsigned u32x4 __attribute__((ext_vector_type(4)));
constexpr int BM = 256, BK = 64, HALF = 128, HTB = HALF * BK * 2  , STAGE_BYTES = 8 * HTB, NXCD = 8, WGM = 8;

__host__ __device__ __forceinline__ int lds_byte(int r, int c) { const int st = (r >> 4) * 2 + (c >> 5), rr = r & 15, cc = c & 31, ob = rr * 64 + cc * 2; return st * 1024 + (ob ^ (((ob >> 9) & 1) << 5)); }
__host__ __device__ __forceinline__ void stage_rc(int b, int& R, int& C) { const int st = b / 1024, sb = b % 1024, swz = sb ^ (((sb >> 9) & 1) << 5); R = (st >> 1) * 16 + swz / 64; C = (st & 1) * 32 + (swz % 64) / 2; }
__host__ __device__ __forceinline__ int perm32(int rho) { const int n = rho >> 4, i = rho & 15; return 8 * (i >> 2) + 4 * n + (i & 3); }

struct Unit { int pm, pn; };
struct Gemm { const bf16_t* A; const bf16_t* Bt; int M, N, K; };

struct StaticOrder {
    int nM, nN, nwg, G, c;
    __host__ __device__ void init(int M, int N, int G_, int c_) { nM = M / BM; nN = N / BM; nwg = nM * nN; G = G_; c = c_; }
    __host__ __device__ bool next(int i, Unit& u) const {
        const long L = (long)i * G + c; if (L >= nwg) return false;
        int wgid = (int)L; { const int q = nwg / NXCD, r = nwg % NXCD, xcd = wgid % NXCD, off = wgid / NXCD; wgid = (xcd < r ? xcd * (q + 1) : r * (q + 1) + (xcd - r) * q) + off; }
        const int nig = WGM * nN, gid = wgid / nig, fm = gid * WGM, gsz = (nM - fm) < WGM ? (nM - fm) : WGM;
        u.pm = fm + ((wgid % nig) % gsz); u.pn = (wgid % nig) / gsz; return true;
    }
    __device__ __forceinline__ void a_ready(const Unit&) const {}
    __device__ __forceinline__ void done(const Unit&) const {}
};


struct SampleOrder {
    int d, nd;
    __device__ __forceinline__ bool next(int i, Unit& u) const { const int j = d + i * nd; if (j >= 2 * (cfg::NIN / BM)) return false; u.pm = cfg::NP / BM + j / (cfg::NIN / BM); u.pn = j % (cfg::NIN / BM); return true; }
    __device__ __forceinline__ void a_ready(const Unit&) const {}
    __device__ __forceinline__ void done(const Unit&) const {}
};

__device__ __forceinline__ unsigned cvt_pk_bf16(float lo, float hi) { unsigned r; asm volatile("v_cvt_pk_bf16_f32 %0, %1, %2" : "=v"(r) : "v"(lo), "v"(hi)); return r; }
__device__ __forceinline__ float ex2(float x) { return __builtin_amdgcn_exp2f(x); }
__device__ __forceinline__ float rcpf_(float x) { return __builtin_amdgcn_rcpf(x); }
__device__ __forceinline__ float minraw(float x, float c) { float r; asm("v_min_f32 %0, %1, %2" : "=v"(r) : "v"(x), "v"(c)); return r; }
__device__ __forceinline__ float sigm(float x) { return rcpf_(1.0f + ex2(x * -1.4426950408889634f)); }
__device__ __forceinline__ u32x4 pack8(f32x4 a, f32x4 b) { u32x4 w; w.x = cvt_pk_bf16(a[0], a[1]); w.y = cvt_pk_bf16(a[2], a[3]); w.z = cvt_pk_bf16(b[0], b[1]); w.w = cvt_pk_bf16(b[2], b[3]); return w; }

struct EpiInProj {
    static constexpr bool PERM = true, AFTER_DRAIN = false;
    bf16_t *Qb, *Kb, *Vb, *HQ, *HV, *HG; float* LF; float* out; const float *qg, *kg, *lbl;
    __device__ __forceinline__ void operator()(const f32x4 (&acc)[2][2][4][2], const Unit& u, int wr, int wc, int fr, int fq) const {
        const int type = u.pn >> 1, head = (u.pn & 1) * 4 + wc;
        const int row0 = u.pm * BM + wr * 64 + fr;
        const int fcol = head * 64 + 8 * fq;
        const bool prompt = u.pm < cfg::NP / BM;
        if (type <= 1) {
            const float* g = type == 0 ? qg : kg;
            f32x4 gv[2][2];
#pragma unroll
            for (int bj = 0; bj < 2; ++bj)
#pragma unroll
                for (int n = 0; n < 2; ++n) gv[bj][n] = *(const f32x4*)(g + 32 * bj + 8 * fq + 4 * n);
            const float post = type == 0 ? cfg::QSCALE : 1.0f;
            bf16_t* ob = type == 0 ? Qb : Kb;
            float* kof = prompt ? out + cfg::O_KP : out + cfg::O_KS - (size_t)cfg::NP * 512;
#pragma unroll
            for (int ai = 0; ai < 2; ++ai)
#pragma unroll
                for (int m = 0; m < 4; ++m) {
                    float ss = 0.f;
#pragma unroll
                    for (int bj = 0; bj < 2; ++bj)
#pragma unroll
                        for (int n = 0; n < 2; ++n) { const f32x4 x = acc[ai][bj][m][n]; ss += (x[0] * x[0] + x[1] * x[1]) + (x[2] * x[2] + x[3] * x[3]); }
                    ss += __shfl_xor(ss, 16); ss += __shfl_xor(ss, 32);
                    const float rstd = __builtin_amdgcn_rsqf(ss * (1.0f / 64.0f) + cfg::EPS);
                    const size_t row = (size_t)(row0 + ai * HALF + m * 16);
#pragma unroll
                    for (int bj = 0; bj < 2; ++bj) {
                        const f32x4 v0 = acc[ai][bj][m][0] * rstd * gv[bj][0], v1 = acc[ai][bj][m][1] * rstd * gv[bj][1];
                        if (type == 1) { float* kp = kof + row * 512 + fcol + 32 * bj; *(f32x4*)kp = v0; *(f32x4*)(kp + 4) = v1; }
                        *(u32x4*)(ob + row * 512 + fcol + 32 * bj) = pack8(v0 * post, v1 * post);
                    }
                }
        } else if (type == 2) {
            float* vof = prompt ? out + cfg::O_VP : out + cfg::O_VS - (size_t)cfg::NP * 512;
#pragma unroll
            for (int ai = 0; ai < 2; ++ai)
#pragma unroll
                for (int m = 0; m < 4; ++m) { const size_t row = (size_t)(row0 + ai * HALF + m * 16);
#pragma unroll
                    for (int bj = 0; bj < 2; ++bj) { const f32x4 v0 = acc[ai][bj][m][0], v1 = acc[ai][bj][m][1];
                        float* vp = vof + row * 512 + fcol + 32 * bj; *(f32x4*)vp = v0; *(f32x4*)(vp + 4) = v1;
                        *(u32x4*)(Vb + row * 512 + fcol + 32 * bj) = pack8(v0, v1); } }
        } else if (type == 4) {
            f32x4 lb[2][2];
#pragma unroll
            for (int bj = 0; bj < 2; ++bj)
#pragma unroll
                for (int n = 0; n < 2; ++n) { const f32x4 l0 = *(const f32x4*)(lbl + fcol + 32 * bj + 4 * n), l1 = *(const f32x4*)(lbl + 512 + fcol + 32 * bj + 4 * n);
#pragma unroll
                    for (int i = 0; i < 4; ++i) lb[bj][n][i] = sigm(l0[i] - l1[i]); }
#pragma unroll
            for (int ai = 0; ai < 2; ++ai)
#pragma unroll
                for (int m = 0; m < 4; ++m) { const size_t row = (size_t)(row0 + ai * HALF + m * 16);
#pragma unroll
                    for (int bj = 0; bj < 2; ++bj)
#pragma unroll
                        for (int n = 0; n < 2; ++n) { f32x4 o;
#pragma unroll
                            for (int i = 0; i < 4; ++i) { const float l = lb[bj][n][i], f = l + (1.0f - l) * sigm(acc[ai][bj][m][n][i]); o[i] = __builtin_amdgcn_logf(f) * 0.6931471805599453f; }
                            *(f32x4*)(LF + row * 512 + fcol + 32 * bj + 4 * n) = o; } }
        } else {
            bf16_t* ob = type == 3 ? HQ : (type == 5 ? HV : HG);
            const bool act = type != 5;
#pragma unroll
            for (int ai = 0; ai < 2; ++ai)
#pragma unroll
                for (int m = 0; m < 4; ++m) { const size_t row = (size_t)(row0 + ai * HALF + m * 16);
#pragma unroll
                    for (int bj = 0; bj < 2; ++bj) { f32x4 v0 = acc[ai][bj][m][0], v1 = acc[ai][bj][m][1];
                        if (act) {
#pragma unroll
                            for (int i = 0; i < 4; ++i) { v0[i] = v0[i] * sigm(v0[i]); v1[i] = v1[i] * sigm(v1[i]); } }
                        *(u32x4*)(ob + row * 512 + fcol + 32 * bj) = pack8(v0, v1); } }
        }
    }
};
struct EpiResGate {
    static constexpr bool PERM = true, AFTER_DRAIN = false;
    const float *base_p, *base_s; float* out; const float* ada; int goff;
    __device__ __forceinline__ void operator()(const f32x4 (&acc)[2][2][4][2], const Unit& u, int wr, int wc, int fr, int fq) const {
        const int row0 = u.pm * BM + wr * 64 + fr, col0 = u.pn * BM + wc * 32 + 8 * fq;
#pragma unroll
        for (int ai = 0; ai < 2; ++ai)
#pragma unroll
            for (int m = 0; m < 4; ++m) { const int row = row0 + ai * HALF + m * 16;
                const int ar = row < cfg::NP ? (row >> 11) : 8 + ((row - cfg::NP) >> 2);
                const float* bp = row < cfg::NP ? base_p + (size_t)row * 1024 : base_s + (size_t)(row - cfg::NP) * 1024;
                const float* gp = ada + (size_t)ar * cfg::NADA + goff; float* op = out + (size_t)row * 1024;
#pragma unroll
                for (int bj = 0; bj < 2; ++bj)
#pragma unroll
                    for (int n = 0; n < 2; ++n) { const int c = col0 + bj * HALF + 4 * n; const f32x4 x = *(const f32x4*)(bp + c), g = *(const f32x4*)(gp + c);
                        *(f32x4*)(op + c) = x + g * acc[ai][bj][m][n]; } }
    }
};
struct EpiRelu2 {
    static constexpr bool PERM = true, AFTER_DRAIN = false;
    bf16_t* O; int ldc;
    __device__ __forceinline__ void operator()(const f32x4 (&acc)[2][2][4][2], const Unit& u, int wr, int wc, int fr, int fq) const {
        const int row0 = u.pm * BM + wr * 64 + fr, col0 = u.pn * BM + wc * 32 + 8 * fq;
#pragma unroll
        for (int ai = 0; ai < 2; ++ai)
#pragma unroll
            for (int m = 0; m < 4; ++m) { bf16_t* rowp = O + (size_t)(row0 + ai * HALF + m * 16) * ldc + col0;
#pragma unroll
                for (int bj = 0; bj < 2; ++bj) { f32x4 v0 = acc[ai][bj][m][0], v1 = acc[ai][bj][m][1];
#pragma unroll
                    for (int i = 0; i < 4; ++i) { const float a = fmaxf(v0[i], 0.f), b = fmaxf(v1[i], 0.f); v0[i] = a * a; v1[i] = b * b; }
                    *(u32x4*)(rowp + bj * HALF) = pack8(v0, v1); } }
    }
};

template <class Epi, class Sched, bool ALIGN_EPI = false, bool SP2 = false>
__device__ __forceinline__ void gemm_phase(PG8_LAS unsigned char* lds, const Gemm g, const Sched& S, const Epi& E) {
    const int tid = threadIdx.x, wid = __builtin_amdgcn_readfirstlane(tid >> 6), lane = tid & 63, wr = wid >> 2, wc = wid & 3, fr = lane & 15, fq = lane >> 4;
    const int K = g.K, nt = K / BK;
    unsigned voffA[2], voffB[2];
#pragma unroll
    for (int i = 0; i < 2; ++i) { int R, C; stage_rc(tid * 16 + i * 8192, R, C); const int Rb = Epi::PERM ? ((R & ~31) + perm32(R & 31)) : R;
        voffA[i] = (unsigned)(R * K + C) * 2u; voffB[i] = (unsigned)(Rb * K + C) * 2u; }
    const size_t kstep = (size_t)(BK * 2);
    const size_t hstep = (size_t)HALF * K * 2;
    const size_t tstep = 2 * hstep;
    const unsigned ldsw = (unsigned)wid * 1024u;
    const int aoff = lds_byte(wr * 64 + fr, fq * 8), boff = lds_byte(wc * 32 + fr, fq * 8);
#define PG8_SA(b, h) (((b) * 2 + (h)) * HTB)
#define PG8_SB(b, h) ((4 + (b) * 2 + (h)) * HTB)
#define PG8_STAGE(bufoff, gbase, voff) do { _Pragma("unroll") for (int _i = 0; _i < 2; ++_i) \
        __builtin_amdgcn_global_load_lds((const unsigned*)((const char*)(gbase) + (voff)[_i]), (PG8_LAS unsigned*)(lds + (bufoff) + ldsw + _i * 8192), 16, 0, 0); } while (0)
#define PG8_LDA(dst, b, h) do { _Pragma("unroll") for (int m = 0; m < 4; ++m) _Pragma("unroll") for (int k = 0; k < 2; ++k) dst[m][k] = *(const PG8_LAS bf16x8*)(lds + PG8_SA(b, h) + aoff + m * 2048 + k * 1024); } while (0)
#define PG8_LDB(dst, b, h) do { _Pragma("unroll") for (int n = 0; n < 2; ++n) _Pragma("unroll") for (int k = 0; k < 2; ++k) dst[n][k] = *(const PG8_LAS bf16x8*)(lds + PG8_SB(b, h) + boff + n * 2048 + k * 1024); } while (0)
#define PG8_MMA(ai, bj, At, Bt) do { __builtin_amdgcn_s_setprio(1); _Pragma("unroll") for (int m = 0; m < 4; ++m) _Pragma("unroll") for (int n = 0; n < 2; ++n) _Pragma("unroll") for (int k = 0; k < 2; ++k) \
        acc[ai][bj][m][n] = __builtin_amdgcn_mfma_f32_16x16x32_bf16(Bt[n][k], At[m][k], acc[ai][bj][m][n], 0, 0, 0); __builtin_amdgcn_s_setprio(0); } while (0)
#define PG8_WAIT_V(n) asm volatile("s_waitcnt vmcnt(" #n ")" ::: "memory")
#define PG8_WAIT_L(n) asm volatile("s_waitcnt lgkmcnt(" #n ")" ::: "memory")
#define PG8_BAR __builtin_amdgcn_s_barrier()
#define PG8_SCHED __builtin_amdgcn_sched_barrier(0)
    Unit cur, nxt; int ui = 0;
    if (!S.next(0, cur)) return;
    f32x4 acc[2][2][4][2];
#pragma unroll
    for (int a = 0; a < 2; ++a)
#pragma unroll
        for (int b = 0; b < 2; ++b)
#pragma unroll
            for (int m = 0; m < 4; ++m)
#pragma unroll
                for (int n = 0; n < 2; ++n) acc[a][b][m][n] = (f32x4){0.f, 0.f, 0.f, 0.f};
    bf16x8 At[4][2], B0[2][2], B1[2][2];
    const char* cA = (const char*)g.A + (size_t)cur.pm * tstep; const char* cB = (const char*)g.Bt + (size_t)cur.pn * tstep;
    S.a_ready(cur);
    if constexpr (SP2) {
        PG8_STAGE(PG8_SB(0, 0), cB, voffB); PG8_STAGE(PG8_SB(0, 1), cB + hstep, voffB); PG8_STAGE(PG8_SA(0, 0), cA, voffA); PG8_STAGE(PG8_SA(0, 1), cA + hstep, voffA);
        if (wr == 1) PG8_BAR;
        PG8_WAIT_V(2); PG8_BAR;
        PG8_STAGE(PG8_SB(1, 0), cB + kstep, voffB); PG8_STAGE(PG8_SA(1, 0), cA + kstep, voffA); PG8_STAGE(PG8_SB(1, 1), cB + hstep + kstep, voffB);
        PG8_WAIT_V(6); PG8_BAR;
    } else {
        PG8_STAGE(PG8_SB(0, 0), cB, voffB); PG8_STAGE(PG8_SA(0, 0), cA, voffA); PG8_STAGE(PG8_SB(0, 1), cB + hstep, voffB); PG8_STAGE(PG8_SA(0, 1), cA + hstep, voffA);
        if (wr == 1) PG8_BAR;
        PG8_WAIT_V(4); PG8_BAR;
        PG8_STAGE(PG8_SB(1, 0), cB + kstep, voffB); PG8_STAGE(PG8_SA(1, 0), cA + kstep, voffA); PG8_STAGE(PG8_SB(1, 1), cB + hstep + kstep, voffB);
        PG8_WAIT_V(6); PG8_BAR;
    }
    for (;;) {
        const bool has_next = S.next(ui + 1, nxt);
        const char* nA = has_next ? (const char*)g.A + (size_t)nxt.pm * tstep : cA; const char* nB = has_next ? (const char*)g.Bt + (size_t)nxt.pn * tstep : cB;
        for (int t = 0; t < nt; t += 2) {
            const bool last = (t == nt - 2);
            const char* a1 = cA + (size_t)(t + 1) * kstep;
            const char* a2 = last ? nA : cA + (size_t)(t + 2) * kstep; const char* b2 = last ? nB : cB + (size_t)(t + 2) * kstep;
            const char* a3 = a2 + kstep; const char* b3 = b2 + kstep;
            if (last && has_next) S.a_ready(nxt);
            if constexpr (SP2) {
            PG8_LDB(B0, 0, 0); PG8_LDB(B1, 0, 1); PG8_SCHED; PG8_LDA(At, 0, 0); PG8_STAGE(PG8_SA(1, 1), a1 + hstep, voffA);
            PG8_WAIT_V(8); PG8_WAIT_L(0); PG8_BAR; PG8_MMA(0, 0, At, B0); PG8_MMA(0, 1, At, B1); PG8_BAR; PG8_SCHED;
            PG8_LDA(At, 0, 1); PG8_STAGE(PG8_SB(0, 0), b2, voffB); PG8_STAGE(PG8_SB(0, 1), b2 + hstep, voffB); PG8_STAGE(PG8_SA(0, 0), a2, voffA);
            PG8_WAIT_V(8); PG8_WAIT_L(0); PG8_BAR; PG8_MMA(1, 0, At, B0); PG8_MMA(1, 1, At, B1); PG8_BAR; PG8_SCHED;
            PG8_LDB(B0, 1, 0); PG8_LDB(B1, 1, 1); PG8_SCHED; PG8_LDA(At, 1, 0); PG8_STAGE(PG8_SA(0, 1), a2 + hstep, voffA);
            PG8_WAIT_V(8); PG8_WAIT_L(0); PG8_BAR; PG8_MMA(0, 0, At, B0); PG8_MMA(0, 1, At, B1); PG8_BAR; PG8_SCHED;
            PG8_LDA(At, 1, 1); PG8_STAGE(PG8_SB(1, 0), b3, voffB); PG8_STAGE(PG8_SB(1, 1), b3 + hstep, voffB); PG8_STAGE(PG8_SA(1, 0), a3, voffA);
            PG8_WAIT_V(8); PG8_WAIT_L(0); PG8_BAR; PG8_MMA(1, 0, At, B0); PG8_MMA(1, 1, At, B1); PG8_BAR; PG8_SCHED;
            } else {
            PG8_LDB(B0, 0, 0); PG8_SCHED; PG8_LDA(At, 0, 0); PG8_STAGE(PG8_SA(1, 1), a1 + hstep, voffA);
            PG8_WAIT_L(8); PG8_BAR; PG8_WAIT_L(0); PG8_MMA(0, 0, At, B0); PG8_BAR; PG8_SCHED;
            PG8_LDB(B1, 0, 1); PG8_STAGE(PG8_SB(0, 0), b2, voffB);
            PG8_BAR; PG8_WAIT_L(0); PG8_MMA(0, 1, At, B1); PG8_BAR;
            PG8_LDA(At, 0, 1); PG8_STAGE(PG8_SA(0, 0), a2, voffA);
            PG8_BAR; PG8_WAIT_L(0); PG8_MMA(1, 0, At, B0); PG8_BAR; PG8_SCHED;
            PG8_STAGE(PG8_SB(0, 1), b2 + hstep, voffB);
            PG8_WAIT_V(6); PG8_BAR; PG8_MMA(1, 1, At, B1); PG8_BAR;
            PG8_LDB(B0, 1, 0); PG8_SCHED; PG8_LDA(At, 1, 0); PG8_STAGE(PG8_SA(0, 1), a2 + hstep, voffA);
            PG8_WAIT_L(8); PG8_BAR; PG8_WAIT_L(0); PG8_MMA(0, 0, At, B0); PG8_BAR; PG8_SCHED;
            PG8_LDB(B1, 1, 1); PG8_STAGE(PG8_SB(1, 0), b3, voffB);
            PG8_BAR; PG8_WAIT_L(0); PG8_MMA(0, 1, At, B1); PG8_BAR;
            PG8_LDA(At, 1, 1); PG8_STAGE(PG8_SA(1, 0), a3, voffA);
            PG8_BAR; PG8_WAIT_L(0); PG8_MMA(1, 0, At, B0); PG8_BAR; PG8_SCHED;
            PG8_STAGE(PG8_SB(1, 1), b3 + hstep, voffB);
            PG8_WAIT_V(6); PG8_BAR; PG8_MMA(1, 1, At, B1); PG8_BAR;
            }
        }
        if constexpr (ALIGN_EPI) { if (wr == 0) PG8_BAR; }
        if constexpr (!Epi::AFTER_DRAIN) { E(acc, cur, wr, wc, fr, fq); S.done(cur); }
        if (!has_next) break;
#pragma unroll
        for (int a = 0; a < 2; ++a)
#pragma unroll
            for (int b = 0; b < 2; ++b)
#pragma unroll
                for (int m = 0; m < 4; ++m)
#pragma unroll
                    for (int n = 0; n < 2; ++n) acc[a][b][m][n] = (f32x4){0.f, 0.f, 0.f, 0.f};
        cur = nxt; cA = nA; cB = nB; ++ui;
        if constexpr (ALIGN_EPI) { if (wr == 1) PG8_BAR; }
    }
    PG8_WAIT_V(0);
    if constexpr (!ALIGN_EPI) { if (wr == 0) PG8_BAR; }
    PG8_BAR;
    if constexpr (Epi::AFTER_DRAIN) { E.fused(acc, cur, wr, wc, fr, fq, lds, wid, lane); S.done(cur); }
#undef PG8_SA
#undef PG8_SB
#undef PG8_STAGE
#undef PG8_LDA
#undef PG8_LDB
#undef PG8_MMA
#undef PG8_WAIT_V
#undef PG8_WAIT_L
#undef PG8_BAR
#undef PG8_SCHED
}
}

constexpr int NWAVES = 8;
#ifndef MK_N_LAUNCHES
#define MK_N_LAUNCHES 1
#endif
constexpr int N_LAUNCHES = MK_N_LAUNCHES;
constexpr int NPHASE = 9;
using namespace cfg;

constexpr size_t MiB = 1u << 20;
constexpr size_t WS_CTL = 0, CTL_ZERO_BYTES = 1 * MiB;
constexpr size_t WS_WIN = 2 * MiB, WS_WOUT = 9 * MiB, WS_WUP = 11 * MiB, WS_WDN = 19 * MiB;
constexpr size_t WS_ADA = 27 * MiB;
constexpr size_t WS_DPO = 31 * MiB, WS_DPP = 34 * MiB;
constexpr size_t WS_H = 36 * MiB;
constexpr size_t WS_Q = 70 * MiB, WS_K = 87 * MiB, WS_V = 104 * MiB, WS_HQ = 121 * MiB, WS_HV = 138 * MiB, WS_HG = 155 * MiB;
constexpr size_t WS_LF = 172 * MiB;
constexpr size_t WS_MIX = 205 * MiB;
constexpr size_t WS_HUP = 240 * MiB, WS_END = 372 * MiB;
constexpr int CW_TMO = 0, CW_BAR = 4096, CW_Q = 8192, CW_SAMPLE = 9216, CW_P2DONE = 9280;

constexpr int RING_OFF = 0, RING_BYTES = 131072;
constexpr int LDSCTL_OFF = RING_BYTES, MISC_OFF = LDSCTL_OFF + 320;
constexpr int LDS_BYTES = 147456;

#define GAS __attribute__((address_space(1)))
#define LAS __attribute__((address_space(3)))
typedef unsigned short bf16;
typedef unsigned v4u __attribute__((ext_vector_type(4)));
typedef unsigned v2u __attribute__((ext_vector_type(2)));
typedef float f32x4 __attribute__((ext_vector_type(4)));
typedef float f32x16 __attribute__((ext_vector_type(16)));
typedef short bf16x8 __attribute__((ext_vector_type(8)));
typedef short s16x4 __attribute__((ext_vector_type(4)));
typedef GAS unsigned gu32;
#define RLX_AGENT __ATOMIC_RELAXED, __HIP_MEMORY_SCOPE_AGENT
#define LDS_WAIT() asm volatile("s_waitcnt lgkmcnt(0)" ::: "memory")
#define VM_WAIT() asm volatile("s_waitcnt vmcnt(0)" ::: "memory")
__device__ __forceinline__ unsigned f2bf(float f) { unsigned u = __builtin_bit_cast(unsigned, f); return (u + 0x7fffu + ((u >> 16) & 1u)) >> 16; }
__device__ __forceinline__ unsigned pk2(float lo, float hi) { return pg8::cvt_pk_bf16(lo, hi); }
__device__ __forceinline__ float bf2f(unsigned short b) { return __builtin_bit_cast(float, (unsigned)b << 16); }
__device__ __forceinline__ float bflo(unsigned w) { return __builtin_bit_cast(float, w << 16); }
__device__ __forceinline__ float bfhi(unsigned w) { return __builtin_bit_cast(float, w & 0xffff0000u); }
using pg8::ex2; using pg8::rcpf_; using pg8::sigm; using pg8::minraw;
__device__ __forceinline__ float wave_sum(float v) {
#pragma unroll
    for (int o = 1; o < 64; o <<= 1) v += __shfl_xor(v, o);
    return v;
}
__device__ __forceinline__ s16x4 vtr(const LAS unsigned char* p) { return __builtin_bit_cast(s16x4, __builtin_amdgcn_ds_read_tr16_b64_v4i16((LAS s16x4*)p)); }
__device__ __forceinline__ bf16x8 cat8(s16x4 a, s16x4 b) { return (bf16x8){a[0], a[1], a[2], a[3], b[0], b[1], b[2], b[3]}; }

#define XB_TMO      128
#define XB_XCNT(j)  (256  + 64 * (j))
#define XB_XSUB(j)  (1280 + 64 * (j))
#define XB_XGEN(j)  (2304 + 64 * (j))
#define XB_TOP      3328
#define XB_TOPGEN   3392
#define XCD_BAR_WORDS 3456
#define XB_SPIN_CAP (1u << 18)

__device__ __forceinline__ unsigned xb_ld(unsigned* p)              { return __hip_atomic_load(p, __ATOMIC_RELAXED, __HIP_MEMORY_SCOPE_AGENT); }
__device__ __forceinline__ unsigned xb_add(unsigned* p, unsigned v) { return __hip_atomic_fetch_add(p, v, __ATOMIC_RELAXED, __HIP_MEMORY_SCOPE_AGENT); }
__device__ __forceinline__ unsigned xb_xcc_id() { return (unsigned)__builtin_amdgcn_s_getreg((3 << 11) | 20) & 0xFu; }
#define XB_SPIN(cond, bar) do { unsigned _sp = 0; while (cond) { __builtin_amdgcn_s_sleep(1); \
    if ((++_sp & 255u) == 0u) { if (xb_ld(&(bar)[XB_TMO])) break; if (_sp > XB_SPIN_CAP) { atomicAdd(&(bar)[XB_TMO], 1u); break; } } } } while (0)

struct XcdBarrier {
    unsigned* bar; unsigned x;
    volatile LAS unsigned* st;
};

__device__ __forceinline__ XcdBarrier xcd_barrier_post(unsigned* bar, volatile LAS unsigned* st) {
    XcdBarrier b; b.bar = bar; b.x = xb_xcc_id(); b.st = st;
    if (threadIdx.x == 0) (void)xb_add(&bar[XB_XCNT(b.x)], 1u);
    return b;
}
__device__ __forceinline__ void xcd_barrier_complete(unsigned* bar, unsigned x, unsigned& nloc, unsigned& nx) {
    const unsigned G = gridDim.x * gridDim.y * gridDim.z;
    unsigned sum, cnt, mine, sp = 0u;
    for (;;) {
        sum = 0u; cnt = 0u; mine = 0u;
#pragma unroll
        for (unsigned j = 0; j < 16; ++j) { const unsigned c = xb_ld(&bar[XB_XCNT(j)]); sum += c; cnt += (c > 0u) ? 1u : 0u; mine = (j == x) ? c : mine; }
        if (sum == G) break;
        __builtin_amdgcn_s_sleep(1);
        if ((++sp & 255u) == 0u) { if (xb_ld(&bar[XB_TMO])) break; if (sp > XB_SPIN_CAP) { atomicAdd(&bar[XB_TMO], 1u); break; } }
    }
    nloc = mine > 0u ? mine : 1u; nx = cnt > 0u ? cnt : 1u;
}

__device__ __forceinline__ void xcd_barrier(const XcdBarrier& b) {
    asm volatile("s_waitcnt vmcnt(0)" ::: "memory");
    __syncthreads();
    if (threadIdx.x == 0) {
        unsigned* bar = b.bar;
        __builtin_amdgcn_s_waitcnt(0);
        unsigned nloc = b.st[0], nx = b.st[1];
        if (nloc == 0u) { xcd_barrier_complete(bar, b.x, nloc, nx); b.st[0] = nloc; b.st[1] = nx; }
        const unsigned old = xb_add(&bar[XB_XSUB(b.x)], 1u);
        const unsigned gen = old / nloc;
        if (old + 1u == (gen + 1u) * nloc) {
            __builtin_amdgcn_fence(__ATOMIC_RELEASE, "agent");
            asm volatile("s_waitcnt vmcnt(0)" ::: "memory");
            const unsigned og = xb_add(&bar[XB_TOP], 1u);
            const unsigned tg = og / nx;
            if (og + 1u == (tg + 1u) * nx) xb_add(&bar[XB_TOPGEN], 1u);
            else XB_SPIN(xb_ld(&bar[XB_TOPGEN]) == tg, bar);
            __builtin_amdgcn_fence(__ATOMIC_ACQUIRE, "agent");
            xb_add(&bar[XB_XGEN(b.x)], 1u);
            asm volatile("s_waitcnt vmcnt(0)" ::: "memory");
        } else {
            XB_SPIN(xb_ld(&bar[XB_XGEN(b.x)]) == gen, bar);
            __builtin_amdgcn_fence(__ATOMIC_ACQUIRE, "agent");
            asm volatile("s_waitcnt vmcnt(0)" ::: "memory");
        }
    }
    __syncthreads();
}

__device__ __forceinline__ void wg_signal(gu32* cnt) {
    asm volatile("s_waitcnt vmcnt(0)" ::: "memory");
    __syncthreads();
    if (threadIdx.x == 0) { __builtin_amdgcn_fence(__ATOMIC_RELEASE, "agent"); asm volatile("s_waitcnt vmcnt(0)" ::: "memory"); (void)__hip_atomic_fetch_add(cnt, 1u, RLX_AGENT); }
}
__device__ __forceinline__ void wg_wait_ge(gu32* cnt, unsigned n, gu32* tmo) {
    if (threadIdx.x == 0) {
        unsigned sp = 0;
        while (__hip_atomic_load(cnt, RLX_AGENT) < n) { __builtin_amdgcn_s_sleep(4); if ((++sp & 1023u) == 0u) { if (__hip_atomic_load(tmo, RLX_AGENT) != 0u) break; if (sp > (1u << 22)) { __hip_atomic_store(tmo, 1u, RLX_AGENT); break; } } }
        __builtin_amdgcn_fence(__ATOMIC_ACQUIRE, "agent"); asm volatile("s_waitcnt vmcnt(0)" ::: "memory");
    }
    __syncthreads();
}

struct Args { const float* in[21]; float* out; unsigned char* ws; int ph_lo, ph_hi; };

__device__ __forceinline__ void p0_transpose_item(const float* W, int K, int N, bf16* WT, bool headperm, LAS float* scr, int item, int lane) {
    const int nblk = N / 32, kb = item / nblk, nb = item % nblk, k0 = 64 * kb, n0 = 32 * nb;
#pragma unroll 8
    for (int i = 0; i < 32; ++i) { const int kk = 2 * i + (lane >> 5); scr[kk * 33 + (lane & 31)] = W[(size_t)(k0 + kk) * N + n0 + (lane & 31)]; }
    LDS_WAIT(); asm volatile("" ::: "memory");
    int drow0 = n0;
    if (headperm) { const int g = (n0 & 255) >> 5; drow0 = (n0 & ~255) + 32 * (4 * (g & 1) + (g >> 1)); }
    const int c = lane & 7;
#pragma unroll
    for (int j = 0; j < 4; ++j) { const int n = (lane >> 3) + 8 * j; const LAS float* s = scr + (8 * c) * 33 + n;
        v4u o; o.x = pk2(s[0 * 33], s[1 * 33]); o.y = pk2(s[2 * 33], s[3 * 33]); o.z = pk2(s[4 * 33], s[5 * 33]); o.w = pk2(s[6 * 33], s[7 * 33]);
        *(GAS v4u*)(WT + (size_t)(drow0 + n) * K + k0 + 8 * c) = o; }
    LDS_WAIT(); asm volatile("" ::: "memory");
}
__device__ __forceinline__ float siluf(float x) { return x * sigm(x); }
__device__ __forceinline__ void p0_transpose_rest(const Args& a, LAS unsigned char* lds, int lane, int gw, int ngw) {
    LAS float* scr = (LAS float*)(lds + RING_OFF + (gw % NWAVES) * 16384);
    constexpr int I_OUT = (DM / 64) * (DM / 32), I_UP = (DM / 64) * (DFF / 32), I_DN = (DFF / 64) * (DM / 32);
    for (int it = gw; it < I_OUT + I_UP + I_DN; it += ngw) {
        int r = it;
        if (r < I_OUT) { p0_transpose_item(a.in[18], DM, DM, (bf16*)(a.ws + WS_WOUT), false, scr, r, lane); continue; } r -= I_OUT;
        if (r < I_UP) { p0_transpose_item(a.in[19], DM, DFF, (bf16*)(a.ws + WS_WUP), false, scr, r, lane); continue; } r -= I_UP;
        p0_transpose_item(a.in[20], DFF, DM, (bf16*)(a.ws + WS_WDN), false, scr, r, lane);
    }
}
__device__ __forceinline__ void p0_prologue(const Args& a, LAS unsigned char* lds, int tid, int lane, int wave, int bid, int G, bool defer_rest) {
    unsigned char* ws = a.ws;
    {
        LAS float* scr = (LAS float*)(lds + RING_OFF + wave * 16384);
        const int gw = bid * NWAVES + wave, NGW = G * NWAVES;
        constexpr int I_IN = (DM / 64) * (NIN / 32);
        for (int it = gw; it < I_IN; it += NGW) p0_transpose_item(a.in[12], DM, NIN, (bf16*)(ws + WS_WIN), true, scr, it, lane);
        if (!defer_rest) p0_transpose_rest(a, lds, lane, gw, NGW);
    }
    __syncthreads();
    {
        const float* w_ada = a.in[8]; const float* b_ada = a.in[9]; const float* c_p = a.in[6]; const float* c_s = a.in[7];
        float* ADA = (float*)(ws + WS_ADA);
        LAS bf16* Wt = (LAS bf16*)(lds + RING_OFF);
        constexpr int WST = 1032;
        for (int cb = bid; cb < NADA / 24; cb += G) {
            const int n0 = 24 * cb;
            for (int idx = tid; idx < 1024 * 6; idx += NWAVES * 64) { const int k = idx / 6, c4 = idx % 6;
                const f32x4 v = *(const f32x4*)(w_ada + (size_t)k * NADA + n0 + 4 * c4);
#pragma unroll
                for (int i = 0; i < 4; ++i) Wt[(4 * c4 + i) * WST + k] = (bf16)f2bf(v[i]); }
            for (int idx = tid; idx < 8 * 1024; idx += NWAVES * 64) Wt[(24 + (idx >> 10)) * WST + (idx & 1023)] = 0;
            __syncthreads();
            for (int rt = wave; rt < 9; rt += NWAVES) {
                const int row = 16 * rt + (lane & 15), rowc = row < NADAROW ? row : NADAROW - 1;
                const float* crow = rowc < 8 ? c_p + (size_t)rowc * DM : c_s + (size_t)(rowc - 8) * DM;
                f32x4 acc0 = {0.f, 0.f, 0.f, 0.f}, acc1 = {0.f, 0.f, 0.f, 0.f};
#pragma unroll 4
                for (int ks = 0; ks < 32; ++ks) {
                    const int k = 32 * ks + 8 * (lane >> 4);
                    const f32x4 a0 = *(const f32x4*)(crow + k), a1 = *(const f32x4*)(crow + k + 4);
                    v4u aw; aw.x = pk2(siluf(a0[0]), siluf(a0[1])); aw.y = pk2(siluf(a0[2]), siluf(a0[3])); aw.z = pk2(siluf(a1[0]), siluf(a1[1])); aw.w = pk2(siluf(a1[2]), siluf(a1[3]));
                    const bf16x8 A = __builtin_bit_cast(bf16x8, aw);
                    const bf16x8 B0 = *(const LAS bf16x8*)(Wt + (lane & 15) * WST + k), B1 = *(const LAS bf16x8*)(Wt + (16 + (lane & 15)) * WST + k);
                    acc0 = __builtin_amdgcn_mfma_f32_16x16x32_bf16(A, B0, acc0, 0, 0, 0);
                    acc1 = __builtin_amdgcn_mfma_f32_16x16x32_bf16(A, B1, acc1, 0, 0, 0);
                }
                const int n = lane & 15;
#pragma unroll
                for (int i = 0; i < 4; ++i) { const int r = 16 * rt + 4 * (lane >> 4) + i;
                    if (r < NADAROW) { ADA[(size_t)r * NADA + n0 + n] = acc0[i] + b_ada[n0 + n]; if (n < 8) ADA[(size_t)r * NADA + n0 + 16 + n] = acc1[i] + b_ada[n0 + 16 + n]; } }
            }
            __syncthreads();
        }
    }
}

template <int NR>
__device__ __forceinline__ void norm_mod_rows(const float* src_p, const float* src_s, const float* ADA, int sh_off, int sc_off, const float* gain, bf16* H, int lane, int m0, int mstride) {
    f32x4 v[NR][4], sc[NR][4], sh[NR][4], g[4];
#pragma unroll
    for (int r = 0; r < NR; ++r) { const int m = m0 + r * mstride;
        const float* xr; int ar;
        if (m < NP) { xr = src_p + (size_t)m * DM; ar = m >> 11; } else { xr = src_s + (size_t)(m - NP) * DM; ar = 8 + ((m - NP) >> 2); }
        const float* ap = ADA + (size_t)ar * NADA;
#pragma unroll
        for (int j = 0; j < 4; ++j) { const int c = 4 * (lane + 64 * j); v[r][j] = __builtin_nontemporal_load((const f32x4*)(xr + c)); sc[r][j] = *(const f32x4*)(ap + sc_off + c); sh[r][j] = *(const f32x4*)(ap + sh_off + c); } }
#pragma unroll
    for (int j = 0; j < 4; ++j) g[j] = *(const f32x4*)(gain + 4 * (lane + 64 * j));
#pragma unroll
    for (int r = 0; r < NR; ++r) { const int m = m0 + r * mstride;
        float s = 0.f;
#pragma unroll
        for (int j = 0; j < 4; ++j) s += (v[r][j].x * v[r][j].x + v[r][j].y * v[r][j].y) + (v[r][j].z * v[r][j].z + v[r][j].w * v[r][j].w);
        const float rstd = __builtin_amdgcn_rsqf(wave_sum(s) * (1.f / DM) + EPS);
        unsigned long long* o8 = (unsigned long long*)(H + (size_t)m * DM) + lane;
#pragma unroll
        for (int j = 0; j < 4; ++j) { const f32x4 y = v[r][j] * rstd * g[j] * (1.0f + sc[r][j]) + sh[r][j];
            o8[64 * j] = (unsigned long long)pk2(y.x, y.y) | ((unsigned long long)pk2(y.z, y.w) << 32); } }
}
__device__ __forceinline__ void norm_mod_phase(const float* src_p, const float* src_s, const float* ADA, int sh_off, int sc_off, const float* gain, bf16* H, int lane, int wave, int bid, int G) {
    const int gw = bid * NWAVES + wave, NGW = G * NWAVES;
    int m = gw;
    for (; m + 3 * NGW < MT; m += 4 * NGW) norm_mod_rows<4>(src_p, src_s, ADA, sh_off, sc_off, gain, H, lane, m, NGW);
    for (; m < MT; m += NGW) norm_mod_rows<1>(src_p, src_s, ADA, sh_off, sc_off, gain, H, lane, m, NGW);
}

constexpr int AT_KS = 144, AT_VS = 192;
constexpr int AT_K = 0, AT_V = 2 * 64 * AT_KS, AT_BYTES = AT_V + 3 * 64 * AT_VS;
__device__ __forceinline__ void attn_unit(const bf16* __restrict__ Qb, const bf16* __restrict__ Kb, const bf16* __restrict__ Vb, bf16* MIX, const float* sb_bias,
                                          LAS unsigned char* lds, int tid, int lane, int wave, int b, int h, int qb) {
#define AT_BAR() do { asm volatile("s_waitcnt lgkmcnt(0)" ::: "memory"); __builtin_amdgcn_s_barrier(); asm volatile("" ::: "memory"); } while (0)
    const int r32 = lane & 31, hi = lane >> 5, trel = 32 * wave + r32, grp = wave >> 2;
    const size_t mq = (size_t)b * SEQ + 256 * qb + trel;
    bf16x8 qr[4];
#pragma unroll
    for (int ds = 0; ds < 4; ++ds) qr[ds] = *(const bf16x8*)(Qb + mq * 512 + 64 * h + 16 * ds + 8 * hi);
    const float bias2 = sb_bias[h] * LOG2E;
    f32x16 o0, o1, p0, p1;
#pragma unroll
    for (int i = 0; i < 16; ++i) { o0[i] = 0.f; o1[i] = 0.f; p0[i] = 0.f; p1[i] = 0.f; }
    bf16x8 pw[4];
#pragma unroll
    for (int j = 0; j < 4; ++j) pw[j] = (bf16x8){0, 0, 0, 0, 0, 0, 0, 0};
    float R = 1.0f;
    const int NT = 4 * (qb + 1);
    const int skey = tid >> 3, sch = tid & 7;
    const bf16* kg = Kb + ((size_t)b * SEQ + skey) * 512 + 64 * h + 8 * sch;
    const bf16* vg = Vb + ((size_t)b * SEQ + skey) * 512 + 64 * h + 8 * sch;
#define AT_GOFF(t) ((size_t)(NT - 1 - ((t) < NT ? (t) : NT - 1)) * 64 * 512)
    v4u kA = *(const v4u*)(kg + AT_GOFF(0)), vA = *(const v4u*)(vg + AT_GOFF(0)), kB = *(const v4u*)(kg + AT_GOFF(1)), vB = *(const v4u*)(vg + AT_GOFF(1));
    const int kwr = skey * AT_KS + sch * 16, vwr = skey * AT_VS + sch * 16;
    const int krd = (32 * ((r32 >> 2) & 1) + (r32 & 3) + 4 * (r32 >> 3)) * AT_KS + 16 * hi;
    const int g16 = lane >> 4;
    const int vrd = (32 * (g16 >> 1) + ((lane & 15) >> 2)) * AT_VS + (16 * (g16 & 1) + 4 * (lane & 3)) * 2;
#define AT_SKIP(t) ((t) < 4 && 2 * (3 - (t)) > wave)
    auto stage = [&](const int t, v4u& KR, v4u& VR) __attribute__((always_inline)) {
        *(LAS v4u*)(lds + AT_K + (t & 1) * 64 * AT_KS + kwr) = KR;
        *(LAS v4u*)(lds + AT_V + (t % 3) * 64 * AT_VS + vwr) = VR;
        KR = *(const v4u*)(kg + AT_GOFF(t + 2)); VR = *(const v4u*)(vg + AT_GOFF(t + 2));
    };
    auto segA = [&](const int t) __attribute__((always_inline)) {
        if (t >= 1 && !AT_SKIP(t - 1)) {
            const LAS unsigned char* Vt = lds + AT_V + ((t - 1) % 3) * 64 * AT_VS + vrd;
#pragma unroll
            for (int j = 0; j < 4; ++j) {
                const bf16x8 v0 = cat8(vtr(Vt + j * 8 * AT_VS), vtr(Vt + j * 8 * AT_VS + 4 * AT_VS));
                const bf16x8 v1 = cat8(vtr(Vt + j * 8 * AT_VS + 64), vtr(Vt + j * 8 * AT_VS + 4 * AT_VS + 64));
                o0 = __builtin_amdgcn_mfma_f32_32x32x16_bf16(v0, pw[j], o0, 0, 0, 0);
                o1 = __builtin_amdgcn_mfma_f32_32x32x16_bf16(v1, pw[j], o1, 0, 0, 0);
            }
        }
        if (t < NT && !AT_SKIP(t)) {
            const LAS unsigned char* Kt = lds + AT_K + (t & 1) * 64 * AT_KS + krd;
#pragma unroll
            for (int i = 0; i < 16; ++i) { p0[i] = bias2; p1[i] = bias2; }
#pragma unroll
            for (int ds = 0; ds < 4; ++ds) {
                const bf16x8 a0 = *(const LAS bf16x8*)(Kt + 32 * ds), a1 = *(const LAS bf16x8*)(Kt + 16 * AT_KS + 32 * ds);
                p0 = __builtin_amdgcn_mfma_f32_32x32x16_bf16(a0, qr[ds], p0, 0, 0, 0);
                p1 = __builtin_amdgcn_mfma_f32_32x32x16_bf16(a1, qr[ds], p1, 0, 0, 0);
            }
        }
    };
    auto segB = [&](const int t) __attribute__((always_inline)) {
        if (t >= NT || AT_SKIP(t)) return;
        float e[32], r[32];
#pragma unroll
        for (int i = 0; i < 16; ++i) { e[i] = ex2(minraw(p0[i], 126.0f)); e[16 + i] = ex2(minraw(p1[i], 126.0f)); }
        if (t < 4) {
            const int sb0 = 64 * (3 - t) + 32 * hi;
#pragma unroll
            for (int i = 0; i < 32; ++i) e[i] = (sb0 + i < trel) ? e[i] : 0.0f;
        }
#pragma unroll
        for (int i = 0; i < 32; ++i) r[i] = rcpf_(1.0f + e[i]);
        float T;
        { float t8[8];
#pragma unroll
          for (int i = 0; i < 8; ++i) t8[i] = (r[4 * i] * r[4 * i + 1]) * (r[4 * i + 2] * r[4 * i + 3]);
          T = ((t8[0] * t8[1]) * (t8[2] * t8[3])) * ((t8[4] * t8[5]) * (t8[6] * t8[7])); }
        const auto rr = __builtin_amdgcn_permlane32_swap(__float_as_uint(T), __float_as_uint(T), false, false);
        const float Tlo = __uint_as_float(rr[0]), Thi = __uint_as_float(rr[1]);
        float ca = hi ? R : R * Thi;
        float cb = 1.0f;
#pragma unroll
        for (int i = 15; i >= 0; --i) { ca *= r[16 + i]; e[16 + i] *= ca; cb *= r[i]; e[i] *= cb; }
#pragma unroll
        for (int i = 0; i < 16; ++i) e[i] *= ca;
        R = R * Tlo * Thi;
#pragma unroll
        for (int j = 0; j < 4; ++j) { v4u w; w.x = pk2(e[8 * j], e[8 * j + 1]); w.y = pk2(e[8 * j + 2], e[8 * j + 3]); w.z = pk2(e[8 * j + 4], e[8 * j + 5]); w.w = pk2(e[8 * j + 6], e[8 * j + 7]); pw[j] = __builtin_bit_cast(bf16x8, w); }
    };
    auto iter = [&](const int t, v4u& KN, v4u& VN) __attribute__((always_inline)) {
        AT_BAR();
        if (grp == 1 && t + 1 < NT) stage(t + 1, KN, VN);
        segA(t);
        AT_BAR();
        if (grp == 0 && t + 1 < NT) stage(t + 1, KN, VN);
        segB(t);
    };
    stage(0, kA, vA);
    if (grp == 1) AT_BAR();
    for (int t = 0; t < NT; t += 2) { iter(t, kB, vB); iter(t + 1, kA, vA); }
    AT_BAR();
    segA(NT);
    if (grp == 0) AT_BAR();
#undef AT_SKIP
#undef AT_GOFF
    bf16* op = MIX + mq * DM + 64 * h + 4 * hi;
#pragma unroll
    for (int g4 = 0; g4 < 4; ++g4) {
        v2u w0, w1; w0.x = pk2(o0[4 * g4], o0[4 * g4 + 1]); w0.y = pk2(o0[4 * g4 + 2], o0[4 * g4 + 3]); w1.x = pk2(o1[4 * g4], o1[4 * g4 + 1]); w1.y = pk2(o1[4 * g4 + 2], o1[4 * g4 + 3]);
        *(v2u*)(op + 8 * g4) = w0; *(v2u*)(op + 32 + 8 * g4) = w1; }
    AT_BAR();
#undef AT_BAR
}

template <int CTRL> __device__ __forceinline__ float dppf(float x) { return __builtin_bit_cast(float, __builtin_amdgcn_update_dpp(0, __builtin_bit_cast(int, x), CTRL, 0xf, 0xf, true)); }
template <int CTRL> __device__ __forceinline__ float dppo(float o, float x) { return __builtin_bit_cast(float, __builtin_amdgcn_update_dpp(__builtin_bit_cast(int, o), __builtin_bit_cast(int, x), CTRL, 0xf, 0xf, false)); }
__device__ __forceinline__ float dec_qk(const f32x4 (&kv)[4], const f32x4 (&qv)[4], float bias2, bool newkeys, int lane, float& R) {
    const bool c0 = lane & 1, c1 = lane & 2, c2 = lane & 4, c3 = lane & 8;
    float a8[8];
#pragma unroll
    for (int ip = 0; ip < 2; ++ip) {
        float lo[4], hi[4];
#pragma unroll
        for (int t = 0; t < 4; ++t) { const f32x4 k0 = kv[2 * ip], k1 = kv[2 * ip + 1], q = qv[t];
            lo[t] = __builtin_fmaf(k0.w, q.w, __builtin_fmaf(k0.z, q.z, __builtin_fmaf(k0.y, q.y, k0.x * q.x)));
            hi[t] = __builtin_fmaf(k1.w, q.w, __builtin_fmaf(k1.z, q.z, __builtin_fmaf(k1.y, q.y, k1.x * q.x))); }
#pragma unroll
        for (int t = 0; t < 4; ++t) a8[4 * ip + t] = (c2 ? hi[t] : lo[t]) + dppf<0x141>(c2 ? lo[t] : hi[t]);
    }
    float b4[4];
#pragma unroll
    for (int j = 0; j < 4; ++j) b4[j] = (c0 ? a8[2 * j + 1] : a8[2 * j]) + dppf<0xB1>(c0 ? a8[2 * j] : a8[2 * j + 1]);
    float d2[2];
#pragma unroll
    for (int j = 0; j < 2; ++j) d2[j] = (c1 ? b4[2 * j + 1] : b4[2 * j]) + dppf<0x4E>(c1 ? b4[2 * j] : b4[2 * j + 1]);
    const float sc = (c3 ? d2[1] : d2[0]) + dppf<0x128>(c3 ? d2[0] : d2[1]);
    const int kappa = lane >> 2, t = lane & 3, g = lane >> 4;
    float e = ex2(minraw(sc + bias2, 126.0f));
    if (newkeys) e = (kappa < t) ? e : 0.0f;
    const float r = rcpf_(1.0f + e);
    float x = r;
    x *= dppo<0x104>(1.0f, x);
    x *= dppo<0x108>(1.0f, x);
    const float xe = dppo<0x104>(1.0f, x);
    const float t0 = __shfl(x, t), t1 = __shfl(x, 16 + t), t2 = __shfl(x, 32 + t), t3 = __shfl(x, 48 + t);
    const float pc = (g < 1 ? t1 : 1.0f) * (g < 2 ? t2 : 1.0f) * (g < 3 ? t3 : 1.0f);
    const float w = (e * r) * (xe * pc) * R;
    R *= (t0 * t1) * (t2 * t3);
    return w;
}
__device__ __forceinline__ void dec_pv(const f32x4 (&vv)[4], float w, int lane, f32x4 (&o)[4]) {
#define PVB(i, tt) o[tt] += dppf<0x150 + 4 * (i) + (tt)>(w) * vv[i]
    PVB(0, 0); PVB(0, 1); PVB(0, 2); PVB(0, 3); PVB(1, 0); PVB(1, 1); PVB(1, 2); PVB(1, 3);
    PVB(2, 0); PVB(2, 1); PVB(2, 2); PVB(2, 3); PVB(3, 0); PVB(3, 1); PVB(3, 2); PVB(3, 3);
#undef PVB
}
__device__ __forceinline__ void dec_hgrn_item(const Args& a, int item, int lane);
__device__ __forceinline__ void dec_seq_item(const Args& a, int sb, int lane, int wave) {
    const int h = wave, g = lane >> 4, c = lane & 15;
    const bf16* Qb = (const bf16*)(a.ws + WS_Q);
    const float* ck = a.in[2]; const float* cv = a.in[3]; const int* pt = (const int*)a.in[5] + sb * NPAGE;
    const float bias2 = a.in[15][h] * LOG2E;
    f32x4 qv[4];
#pragma unroll
    for (int t = 0; t < 4; ++t) { const v2u w = *(const v2u*)(Qb + (size_t)(NP + 4 * sb + t) * 512 + 64 * h + 4 * c); qv[t] = (f32x4){bflo(w.x), bfhi(w.x), bflo(w.y), bfhi(w.y)}; }
    f32x4 o[4];
#pragma unroll
    for (int t = 0; t < 4; ++t) o[t] = (f32x4){0.f, 0.f, 0.f, 0.f};
    float R = 1.0f;
    const size_t lane_off = (size_t)(4 * g) * 512 + 64 * h + 4 * c;
    const int pgv = pt[lane & 15];
    f32x4 ka[4], va[4], kb[4], vb[4], kc[4], vc[4];
#pragma unroll
    for (int i = 0; i < 4; ++i) { ka[i] = (f32x4){0.f, 0.f, 0.f, 0.f}; va[i] = ka[i]; kb[i] = ka[i]; vb[i] = ka[i]; kc[i] = ka[i]; vc[i] = ka[i]; }
#define DEC_ADDR(s) (((size_t)__builtin_amdgcn_readlane(pgv, 15 - ((s) >> 3)) * PAGE + 16 * (7 - ((s) & 7))) * 512 + lane_off)
#define DEC_LOAD(XX, base, s) do { const float* p_ = (base) + DEC_ADDR(s); const float* p2_ = p_ + 1024; \
        asm volatile("global_load_dwordx4 %0, %4, off nt\n\tglobal_load_dwordx4 %1, %4, off offset:2048 nt\n\tglobal_load_dwordx4 %2, %5, off nt\n\tglobal_load_dwordx4 %3, %5, off offset:2048 nt" \
                     : "+v"(XX[0]), "+v"(XX[1]), "+v"(XX[2]), "+v"(XX[3]) : "v"(p_), "v"(p2_) : "memory"); } while (0)
#define DEC_WAIT(XX, N) asm volatile("s_waitcnt vmcnt(" #N ")" : "+v"(XX[0]), "+v"(XX[1]), "+v"(XX[2]), "+v"(XX[3]) :: "memory")
    {
        const float* kp = a.out + O_KS + (size_t)(4 * sb) * 512 + 64 * h + 4 * c; const float* vp = a.out + O_VS + (size_t)(4 * sb) * 512 + 64 * h + 4 * c;
        f32x4 kn[4], vn[4];
#pragma unroll
        for (int i = 0; i < 4; ++i) { const int kk = (g == 0) ? i : 0; kn[i] = *(const f32x4*)(kp + kk * 512); vn[i] = *(const f32x4*)(vp + kk * 512); }
        const float w = dec_qk(kn, qv, bias2, true, lane, R);
        dec_pv(vn, w, lane, o);
        asm volatile("s_waitcnt vmcnt(0)" ::: "memory");
    }
    DEC_LOAD(ka, ck, 0); DEC_LOAD(va, cv, 0); DEC_LOAD(kb, ck, 1); DEC_LOAD(vb, cv, 1); DEC_LOAD(kc, ck, 2); DEC_LOAD(vc, cv, 2);
#define SB() __builtin_amdgcn_sched_barrier(0)
#define DEC_STAGE(KK, VV, sn) { SB(); DEC_WAIT(KK, 20); const float w = dec_qk(KK, qv, bias2, false, lane, R); SB(); DEC_LOAD(KK, ck, sn); SB(); DEC_WAIT(VV, 20); dec_pv(VV, w, lane, o); SB(); DEC_LOAD(VV, cv, sn); SB(); }
#pragma unroll 1
    for (int s = 0; s < 126; s += 3) {
        const int s3 = s + 3;
        DEC_STAGE(ka, va, s3) DEC_STAGE(kb, vb, s3 + 1) DEC_STAGE(kc, vc, (s3 + 2 < 128 ? s3 + 2 : 127))
    }
    DEC_STAGE(ka, va, 127) DEC_STAGE(kb, vb, 127)
#undef DEC_STAGE
    asm volatile("s_waitcnt vmcnt(0)" : "+v"(ka[0]), "+v"(ka[1]), "+v"(ka[2]), "+v"(ka[3]), "+v"(va[0]), "+v"(va[1]), "+v"(va[2]), "+v"(va[3]) :: "memory");
    asm volatile("s_waitcnt vmcnt(0)" : "+v"(kb[0]), "+v"(kb[1]), "+v"(kb[2]), "+v"(kb[3]), "+v"(vb[0]), "+v"(vb[1]), "+v"(vb[2]), "+v"(vb[3]) :: "memory");
    asm volatile("s_waitcnt vmcnt(0)" : "+v"(kc[0]), "+v"(kc[1]), "+v"(kc[2]), "+v"(kc[3]), "+v"(vc[0]), "+v"(vc[1]), "+v"(vc[2]), "+v"(vc[3]) :: "memory");
#undef SB
#undef DEC_WAIT
#undef DEC_ADDR
#undef DEC_LOAD
#pragma unroll
    for (int t = 0; t < 4; ++t)
#pragma unroll
        for (int d = 0; d < 4; ++d) { float x = o[t][d]; x += __shfl_xor(x, 16); x += __shfl_xor(x, 32); o[t][d] = x; }
    int lane2 = lane; asm volatile("" : "+v"(lane2));
    bf16* MIX = (bf16*)(a.ws + WS_MIX);
    if ((lane2 >> 4) == 0) {
#pragma unroll
        for (int t = 0; t < 4; ++t) { v2u w; w.x = pk2(o[t].x, o[t].y); w.y = pk2(o[t].z, o[t].w); *(v2u*)(MIX + (size_t)(NP + 4 * sb + t) * DM + 64 * h + 4 * (lane2 & 15)) = w; } }
    dec_hgrn_item(a, sb * 8 + h, lane2);
}

__device__ __forceinline__ void dec_hgrn_item(const Args& a, int item, int lane) {
    const int sb = item >> 3, h = item & 7;
    const float* LF = (const float*)(a.ws + WS_LF); const bf16* HQ = (const bf16*)(a.ws + WS_HQ); const bf16* HV = (const bf16*)(a.ws + WS_HV); const bf16* HG = (const bf16*)(a.ws + WS_HG);
    bf16* MIX = (bf16*)(a.ws + WS_MIX);
    const float* s0 = a.in[4] + (size_t)(sb * 8 + h) * 4096;
    float S[64];
#pragma unroll
    for (int k = 0; k < 64; ++k) S[k] = s0[k * 64 + lane];
    const float gain = a.in[17][lane];
#pragma unroll 1
    for (int t = 0; t < 4; ++t) {
        const size_t m = (size_t)NP + 4 * sb + t;
        const float lf = LF[m * 512 + 64 * h + lane];
        const float f = ex2(lf * LOG2E), kk = 1.0f - f, q = bf2f(HQ[m * 512 + 64 * h + lane]), vt = bf2f(HV[m * 512 + 64 * h + lane]), gt = bf2f(HG[m * 512 + 64 * h + lane]);
        float o = 0.f;
#pragma unroll
        for (int k = 0; k < 64; ++k) {
            const float fk = __builtin_bit_cast(float, __builtin_amdgcn_readlane(__builtin_bit_cast(int, f), k));
            const float kv = __builtin_bit_cast(float, __builtin_amdgcn_readlane(__builtin_bit_cast(int, kk), k));
            const float qk = __builtin_bit_cast(float, __builtin_amdgcn_readlane(__builtin_bit_cast(int, q), k));
            S[k] = fk * S[k] + kv * vt; o += S[k] * qk; }
        const float ss = wave_sum(o * o);
        const float y = o * __builtin_amdgcn_rsqf(ss * (1.0f / 64.0f) + EPS) * gain * gt;
        MIX[m * DM + 512 + 64 * h + lane] = (bf16)f2bf(y);
    }
    float* so = a.out + O_SS + (size_t)(sb * 8 + h) * 4096;
#pragma unroll
    for (int k = 0; k < 64; ++k) so[k * 64 + lane] = S[k];
}

constexpr int HG_SEG = 0, HG_DEC = 2048, HG_QD = 4096, HG_ROW = 144, HG_KD = HG_QD + 64 * HG_ROW, HG_KET = HG_KD + 64 * HG_ROW, HG_V = HG_KET + 64 * HG_ROW, HG_VS = 192,
              HG_OB = HG_V + 64 * HG_VS, HG_OBS = 272, HG_BYTES = HG_OB + 64 * HG_OBS;
__device__ __forceinline__ void hgrn_chain(const Args& a, LAS unsigned char* lds, int tid, int lane, int wave, int b, int h) {
    const float* LF = (const float*)(a.ws + WS_LF); const bf16* HQ = (const bf16*)(a.ws + WS_HQ); const bf16* HV = (const bf16*)(a.ws + WS_HV); const bf16* HG = (const bf16*)(a.ws + WS_HG);
    bf16* MIX = (bf16*)(a.ws + WS_MIX);
    const int k = lane, seg = wave;
    const int tB = tid >> 3, c8 = tid & 7;
    const int r32 = lane & 31, hi = lane >> 5, tb = (wave >> 1) & 1, vb = wave & 1, g16 = lane >> 4;
    f32x16 S0, S1;
#pragma unroll
    for (int i = 0; i < 16; ++i) { S0[i] = 0.f; S1[i] = 0.f; }
    float lfr[8]; unsigned short qh[8]; v4u vld, gld;
#define HG_LOAD(n) do { const size_t m0_ = (size_t)b * SEQ + 64 * (n); \
        _Pragma("unroll") for (int j = 0; j < 8; ++j) { lfr[j] = LF[(m0_ + 8 * seg + j) * 512 + 64 * h + k]; qh[j] = HQ[(m0_ + 8 * seg + j) * 512 + 64 * h + k]; } \
        vld = *(const v4u*)(HV + (m0_ + tB) * 512 + 64 * h + 8 * c8); gld = *(const v4u*)(HG + (m0_ + tB) * 512 + 64 * h + 8 * c8); } while (0)
    HG_LOAD(0);
    LAS float* SEG = (LAS float*)(lds + HG_SEG); LAS float* DEC = (LAS float*)(lds + HG_DEC);
    const f32x4 gn0 = *(const f32x4*)(a.in[17] + 8 * c8), gn1 = *(const f32x4*)(a.in[17] + 8 * c8 + 4);
    const int krd = (32 * ((r32 >> 2) & 1) + (r32 & 3) + 4 * (r32 >> 3)) * HG_ROW + 16 * hi;
    const int vrd_l = (32 * (g16 >> 1) + ((lane & 15) >> 2)) * HG_VS + (32 * vb + 16 * (g16 & 1) + 4 * (lane & 3)) * 2;
    const int vrd_n = (8 * (g16 >> 1) + ((lane & 15) >> 2)) * HG_VS + (32 * vb + 16 * (g16 & 1) + 4 * (lane & 3)) * 2;
#pragma unroll 1
    for (int n = 0; n < SEQ / 64; ++n) {
        const size_t m0 = (size_t)b * SEQ + 64 * n;
        float cum[8];
        { float s = 0.f;
#pragma unroll
          for (int j = 0; j < 8; ++j) { s += lfr[j]; cum[j] = s; } }
        SEG[seg * 64 + k] = cum[7];
        __syncthreads();
        float prefix = 0.f, btot = 0.f;
#pragma unroll
        for (int s = 0; s < 8; ++s) { const float x = SEG[s * 64 + k]; btot += x; prefix += (s < seg) ? x : 0.f; }
        { unsigned kep[4];
#pragma unroll
          for (int j = 0; j < 8; j += 2) {
              float ke2[2];
#pragma unroll
              for (int u = 0; u < 2; ++u) { const int jj = j + u; const float bb = prefix + cum[jj], f = ex2(lfr[jj] * LOG2E), kk = 1.0f - f;
                  const float qd = bf2f(qh[jj]) * ex2(bb * LOG2E), kd = kk * ex2(-bb * LOG2E); ke2[u] = kk * ex2((btot - bb) * LOG2E);
                  *(LAS bf16*)(lds + HG_QD + (8 * seg + jj) * HG_ROW + 2 * k) = (bf16)f2bf(qd);
                  *(LAS bf16*)(lds + HG_KD + (8 * seg + jj) * HG_ROW + 2 * k) = (bf16)f2bf(kd); }
              kep[j >> 1] = pk2(ke2[0], ke2[1]); }
          *(LAS v4u*)(lds + HG_KET + k * HG_ROW + 16 * seg) = (v4u){kep[0], kep[1], kep[2], kep[3]}; }
        if (seg == 0) DEC[k] = ex2(btot * LOG2E);
        *(LAS v4u*)(lds + HG_V + tB * HG_VS + 16 * c8) = vld;
        const v4u gcur = gld;
        __syncthreads();
        if (n + 1 < SEQ / 64) HG_LOAD(n + 1);
        if (wave < 4) {
            f32x16 p0, p1;
#pragma unroll
            for (int i = 0; i < 16; ++i) { p0[i] = 0.f; p1[i] = 0.f; }
#pragma unroll
            for (int ks = 0; ks < 4; ++ks) {
                const bf16x8 a0 = *(const LAS bf16x8*)(lds + HG_KD + krd + 32 * ks), a1 = *(const LAS bf16x8*)(lds + HG_KD + krd + 16 * HG_ROW + 32 * ks);
                const bf16x8 bq = *(const LAS bf16x8*)(lds + HG_QD + (32 * tb + r32) * HG_ROW + 32 * ks + 16 * hi);
                p0 = __builtin_amdgcn_mfma_f32_32x32x16_bf16(a0, bq, p0, 0, 0, 0);
                p1 = __builtin_amdgcn_mfma_f32_32x32x16_bf16(a1, bq, p1, 0, 0, 0);
            }
            const int tq = 32 * tb + r32;
            float e[32];
#pragma unroll
            for (int i = 0; i < 16; ++i) { e[i] = (32 * hi + i <= tq) ? p0[i] : 0.f; e[16 + i] = (32 * hi + 16 + i <= tq) ? p1[i] : 0.f; }
            bf16x8 pw[4];
#pragma unroll
            for (int j = 0; j < 4; ++j) { v4u w; w.x = pk2(e[8 * j], e[8 * j + 1]); w.y = pk2(e[8 * j + 2], e[8 * j + 3]); w.z = pk2(e[8 * j + 4], e[8 * j + 5]); w.w = pk2(e[8 * j + 6], e[8 * j + 7]); pw[j] = __builtin_bit_cast(bf16x8, w); }
            f32x16 o;
#pragma unroll
            for (int i = 0; i < 16; ++i) o[i] = 0.f;
#pragma unroll
            for (int kb = 0; kb < 2; ++kb)
#pragma unroll
                for (int s2 = 0; s2 < 2; ++s2) {
                    const f32x16& Sx = kb ? S1 : S0;
                    v4u aw; aw.x = pk2(Sx[8 * s2], Sx[8 * s2 + 1]); aw.y = pk2(Sx[8 * s2 + 2], Sx[8 * s2 + 3]); aw.z = pk2(Sx[8 * s2 + 4], Sx[8 * s2 + 5]); aw.w = pk2(Sx[8 * s2 + 6], Sx[8 * s2 + 7]);
                    const LAS unsigned char* qp = lds + HG_QD + (32 * tb + r32) * HG_ROW + (32 * kb + 16 * s2 + 4 * hi) * 2;
                    const v2u q0 = *(const LAS v2u*)qp, q1 = *(const LAS v2u*)(qp + 16);
                    const v4u bw = (v4u){q0.x, q0.y, q1.x, q1.y};
                    o = __builtin_amdgcn_mfma_f32_32x32x16_bf16(__builtin_bit_cast(bf16x8, aw), __builtin_bit_cast(bf16x8, bw), o, 0, 0, 0);
                }
#pragma unroll
            for (int j = 0; j < 4; ++j) {
                const bf16x8 vf = cat8(vtr(lds + HG_V + vrd_l + j * 8 * HG_VS), vtr(lds + HG_V + vrd_l + j * 8 * HG_VS + 4 * HG_VS));
                o = __builtin_amdgcn_mfma_f32_32x32x16_bf16(vf, pw[j], o, 0, 0, 0);
            }
#pragma unroll
            for (int g4 = 0; g4 < 4; ++g4) *(LAS f32x4*)(lds + HG_OB + tq * HG_OBS + (32 * vb + 8 * g4 + 4 * hi) * 4) = (f32x4){o[4 * g4], o[4 * g4 + 1], o[4 * g4 + 2], o[4 * g4 + 3]};
#pragma unroll
            for (int g4 = 0; g4 < 4; ++g4) { const f32x4 d0 = *(const LAS f32x4*)(DEC + 8 * g4 + 4 * hi), d1 = *(const LAS f32x4*)(DEC + 32 + 8 * g4 + 4 * hi);
#pragma unroll
                for (int i = 0; i < 4; ++i) { S0[4 * g4 + i] *= d0[i]; S1[4 * g4 + i] *= d1[i]; } }
#pragma unroll
            for (int ts = 0; ts < 4; ++ts) {
                const bf16x8 vf = cat8(vtr(lds + HG_V + vrd_n + ts * 16 * HG_VS), vtr(lds + HG_V + vrd_n + ts * 16 * HG_VS + 4 * HG_VS));
                const bf16x8 k0 = *(const LAS bf16x8*)(lds + HG_KET + r32 * HG_ROW + 32 * ts + 16 * hi), k1 = *(const LAS bf16x8*)(lds + HG_KET + (32 + r32) * HG_ROW + 32 * ts + 16 * hi);
                S0 = __builtin_amdgcn_mfma_f32_32x32x16_bf16(k0, vf, S0, 0, 0, 0);
                S1 = __builtin_amdgcn_mfma_f32_32x32x16_bf16(k1, vf, S1, 0, 0, 0);
            }
        }
        __syncthreads();
        {
            const f32x4 x0 = *(const LAS f32x4*)(lds + HG_OB + tB * HG_OBS + 32 * c8), x1 = *(const LAS f32x4*)(lds + HG_OB + tB * HG_OBS + 32 * c8 + 16);
            float ss = (x0.x * x0.x + x0.y * x0.y) + (x0.z * x0.z + x0.w * x0.w) + (x1.x * x1.x + x1.y * x1.y) + (x1.z * x1.z + x1.w * x1.w);
            ss += __shfl_xor(ss, 1); ss += __shfl_xor(ss, 2); ss += __shfl_xor(ss, 4);
            const float rstd = __builtin_amdgcn_rsqf(ss * (1.0f / 64.0f) + EPS);
            const f32x4 g0 = (f32x4){bflo(gcur.x), bfhi(gcur.x), bflo(gcur.y), bfhi(gcur.y)}, g1 = (f32x4){bflo(gcur.z), bfhi(gcur.z), bflo(gcur.w), bfhi(gcur.w)};
            const f32x4 y0 = x0 * rstd * gn0 * g0, y1 = x1 * rstd * gn1 * g1;
            *(v4u*)(MIX + (m0 + tB) * DM + 512 + 64 * h + 8 * c8) = pg8::pack8(y0, y1);
        }
    }
#undef HG_LOAD
    if (wave < 2) {
        float* so = a.out + O_SP + (size_t)(b * 8 + h) * 4096 + 32 * vb + r32;
#pragma unroll
        for (int r = 0; r < 16; ++r) { const int kr = (r & 3) + 8 * (r >> 2) + 4 * hi; so[(size_t)kr * 64] = S0[r]; so[(size_t)(32 + kr) * 64] = S1[r]; }
    }
    __syncthreads();
}


template <int NCB, int KSPLIT, class Epi>
__device__ __forceinline__ void skinny_gemm(const bf16* __restrict__ As, const bf16* __restrict__ Bt, int N, int K, const Epi& E, LAS unsigned char* lds, int tid, int lane, int wave, int bid, int G) {
    static_assert(NCB * KSPLIT == 4, "8 waves = 2 row halves x NCB column blocks x KSPLIT K slices");
    constexpr int RWG = 64 + 32 * NCB, RW = KSPLIT * RWG, ROWB = 144, BUFB = RW * ROWB, NLD = RW * 8 / 512, REDOFF = 0;
    static_assert(RW * 8 % 512 == 0 && 2 * BUFB <= RING_BYTES, "skinny stage geometry");
    const int r32 = lane & 31, hi = lane >> 5;
    const int ntile = 8 * (N / (32 * NCB));
    const int rh = wave & 1, rest = wave >> 1, cb = rest % NCB, ks = rest / NCB;
    const int kl = K / KSPLIT, nst = kl / 64;
    for (int tile = bid; tile < ntile; tile += G) {
        const int rt = tile & 7, ct = tile >> 3;
        const bf16* src[NLD]; int dst[NLD];
#pragma unroll
        for (int j = 0; j < NLD; ++j) { const int idx = tid + 512 * j, rho = idx >> 3, c16 = idx & 7, q = rho / RWG, w = rho % RWG;
            src[j] = (w < 64 ? As + (size_t)(64 * rt + w) * K : Bt + (size_t)(32 * NCB * ct + (w - 64)) * K) + q * kl + 8 * c16;
            dst[j] = rho * ROWB + 16 * c16; }
        v4u st[NLD];
#pragma unroll
        for (int j = 0; j < NLD; ++j) st[j] = *(const v4u*)(src[j]);
        f32x16 acc;
#pragma unroll
        for (int i = 0; i < 16; ++i) acc[i] = 0.f;
        const int brd = (ks * RWG + 32 * rh + r32) * ROWB + 16 * hi, ard = (ks * RWG + 64 + 32 * cb + r32) * ROWB + 16 * hi;
        for (int s = 0; s < nst; ++s) {
            const int buf = (s & 1) * BUFB;
#pragma unroll
            for (int j = 0; j < NLD; ++j) *(LAS v4u*)(lds + buf + dst[j]) = st[j];
            __syncthreads();
            if (s + 1 < nst) {
#pragma unroll
                for (int j = 0; j < NLD; ++j) st[j] = *(const v4u*)(src[j] + 64 * (s + 1)); }
#pragma unroll
            for (int u = 0; u < 4; ++u) {
                const bf16x8 a = *(const LAS bf16x8*)(lds + buf + ard + 32 * u), b = *(const LAS bf16x8*)(lds + buf + brd + 32 * u);
                acc = __builtin_amdgcn_mfma_f32_32x32x16_bf16(a, b, acc, 0, 0, 0); }
        }
        if (KSPLIT > 1) {
            LAS float* red = (LAS float*)(lds + REDOFF);
            __syncthreads();
            if (ks > 0) {
#pragma unroll
                for (int r = 0; r < 16; ++r) red[(((ks - 1) * 2 + rh) * 16 + r) * 64 + lane] = acc[r]; }
            __syncthreads();
            if (ks == 0) {
#pragma unroll
                for (int p = 0; p < KSPLIT - 1; ++p)
#pragma unroll
                    for (int r = 0; r < 16; ++r) acc[r] += red[((p * 2 + rh) * 16 + r) * 64 + lane]; }
        }
        if (ks == 0) E(acc, 64 * rt + 32 * rh + r32, 32 * (NCB * ct + cb), hi);
        __syncthreads();
    }
}
struct SkEpiResGate {
    const float* base; float* out; const float* ada; int goff;
    __device__ __forceinline__ void operator()(const f32x16& acc, int srow, int n0, int hi) const {
        const float* gp = ada + (size_t)(8 + (srow >> 2)) * NADA + goff;
#pragma unroll
        for (int g4 = 0; g4 < 4; ++g4) { const int c = n0 + 8 * g4 + 4 * hi; const f32x4 x = *(const f32x4*)(base + (size_t)srow * DM + c), g = *(const f32x4*)(gp + c);
            *(f32x4*)(out + (size_t)srow * DM + c) = x + g * (f32x4){acc[4 * g4], acc[4 * g4 + 1], acc[4 * g4 + 2], acc[4 * g4 + 3]}; }
    }
};
struct SkEpiRelu2 {
    bf16* O; int ldc;
    __device__ __forceinline__ void operator()(const f32x16& acc, int srow, int n0, int hi) const {
#pragma unroll
        for (int g4 = 0; g4 < 4; ++g4) { float v[4];
#pragma unroll
            for (int i = 0; i < 4; ++i) { const float x = fmaxf(acc[4 * g4 + i], 0.f); v[i] = x * x; }
            v2u w; w.x = pk2(v[0], v[1]); w.y = pk2(v[2], v[3]); *(v2u*)(O + (size_t)srow * ldc + n0 + 8 * g4 + 4 * hi) = w; }
    }
};

__global__ void __launch_bounds__(NWAVES * 64, 2) hymba_fwd(Args args) {
    extern __shared__ __attribute__((aligned(16))) unsigned char lds_raw[];
    LAS unsigned char* lds = (LAS unsigned char*)lds_raw;
    volatile LAS unsigned* MISC = (volatile LAS unsigned*)(lds + MISC_OFF);
    const int tid0 = threadIdx.x;
    const int G = gridDim.x, bid = blockIdx.x;
    unsigned char* ws = args.ws;
    gu32* ctl = (gu32*)(ws + WS_CTL);
    for (int u = tid0; u < (LDS_BYTES - LDSCTL_OFF) / 4; u += NWAVES * 64) ((LAS unsigned*)(lds + LDSCTL_OFF))[u] = 0u;
    __syncthreads();
    XcdBarrier bar; bar.bar = (unsigned*)(ctl + CW_BAR); bar.x = 0; bar.st = nullptr;
    if (N_LAUNCHES == 1) bar = xcd_barrier_post((unsigned*)(ctl + CW_BAR), MISC + 8);
#define GRID_BAR() do { if (N_LAUNCHES == 1) xcd_barrier(bar); } while (0)
    const int lo = args.ph_lo, hi = args.ph_hi;
#define IN(k) (lo <= (k) && (k) < hi)
#define PHASE_IDS() int tid = tid0; asm volatile("" : "+v"(tid)); const int lane = tid & 63, wave = __builtin_amdgcn_readfirstlane(tid >> 6); (void)lane; (void)wave
    bf16* H = (bf16*)(ws + WS_H); float* ADA = (float*)(ws + WS_ADA); bf16* MIX = (bf16*)(ws + WS_MIX);

    const bool defer_rest = (G - G / 2) > 28 && lo == 0 && hi > 2;
    if (IN(0)) { PHASE_IDS(); p0_prologue(args, lds, tid, lane, wave, bid, G, defer_rest); GRID_BAR(); }
    if (IN(1)) { PHASE_IDS(); norm_mod_phase(args.in[0], args.in[1], ADA, 0, 1024, args.in[10], H, lane, wave, bid, G); GRID_BAR(); }
    const int NGW = G / 2, NDW = G - NGW, dwg = bid - NGW;
    const unsigned n_samp = NDW < 28 ? NDW : 28;
    if (IN(2)) { PHASE_IDS();
        pg8::Gemm g{H, (const bf16*)(ws + WS_WIN), MT, NIN, DM};
        pg8::EpiInProj E{(bf16*)(ws + WS_Q), (bf16*)(ws + WS_K), (bf16*)(ws + WS_V), (bf16*)(ws + WS_HQ), (bf16*)(ws + WS_HV), (bf16*)(ws + WS_HG), (float*)(ws + WS_LF), args.out, args.in[13], args.in[14], args.in[16]};
        if (bid < NGW) { pg8::StaticOrder S; S.init(NP, NIN, NGW, bid); pg8::gemm_phase<pg8::EpiInProj, pg8::StaticOrder, true, true>(lds + RING_OFF, g, S, E); wg_signal(ctl + CW_P2DONE); }
        else if (dwg < 28) { pg8::SampleOrder S{dwg, NDW}; pg8::gemm_phase<pg8::EpiInProj, pg8::SampleOrder, true, true>(lds + RING_OFF, g, S, E); wg_signal(ctl + CW_SAMPLE); }
        else if (defer_rest) p0_transpose_rest(args, lds, lane, (dwg - 28) * NWAVES + wave, (NDW - 28) * NWAVES);
    }
    if (IN(3)) { PHASE_IDS();
#define POP(qi) ({ if (tid == 0) MISC[16] = __hip_atomic_fetch_add(ctl + CW_Q + 64 * (qi), 1u, RLX_AGENT); __syncthreads(); const int it_ = (int)MISC[16]; __syncthreads(); it_; })
#define LAUNDER() int tid_ = tid; asm volatile("" : "+v"(tid_)); const int lane_ = tid_ & 63, wave_ = __builtin_amdgcn_readfirstlane(tid_ >> 6)
        if (bid >= NGW) { LAUNDER(); wg_wait_ge(ctl + CW_SAMPLE, n_samp, ctl + CW_TMO); for (int it = dwg; it < DB; it += NDW) dec_seq_item(args, it, lane_, wave_); }
        wg_wait_ge(ctl + CW_P2DONE, (unsigned)NGW, ctl + CW_TMO);
        { LAUNDER(); for (;;) { const int it = POP(1); if (it >= 64) break; hgrn_chain(args, lds, tid_, lane_, wave_, it >> 3, it & 7); } }
        { LAUNDER(); for (;;) { const int u = POP(2); if (u >= 512) break; const int bh = u & 63;
            attn_unit((const bf16*)(ws + WS_Q), (const bf16*)(ws + WS_K), (const bf16*)(ws + WS_V), MIX, args.in[15], lds, tid_, lane_, wave_, bh >> 3, bh & 7, 7 - (u >> 6)); } }
#undef LAUNDER
#undef POP
        GRID_BAR();
    }
    if (IN(4)) { }
    if (IN(5)) { PHASE_IDS();
        { SkEpiResGate Es{args.in[1], args.out + (size_t)NP * DM, ADA, 2048};
          skinny_gemm<1, 4, SkEpiResGate>(MIX + (size_t)NP * DM, (const bf16*)(ws + WS_WOUT), DM, DM, Es, lds, tid, lane, wave, bid, G); }
        pg8::Gemm g{MIX, (const bf16*)(ws + WS_WOUT), NP, DM, DM}; pg8::StaticOrder S; S.init(NP, DM, G, bid);
        pg8::EpiResGate E{args.in[0], args.in[1], args.out, ADA, 2048};
        pg8::gemm_phase<pg8::EpiResGate, pg8::StaticOrder, true, true>(lds + RING_OFF, g, S, E);
        GRID_BAR();
    }
    if (IN(6)) { PHASE_IDS(); norm_mod_phase(args.out, args.out + (size_t)NP * DM, ADA, 3072, 4096, args.in[11], H, lane, wave, bid, G); GRID_BAR(); }
    if (IN(7)) { PHASE_IDS();
        { SkEpiRelu2 Es{(bf16*)(ws + WS_HUP) + (size_t)NP * DFF, DFF};
          skinny_gemm<4, 1, SkEpiRelu2>(H + (size_t)NP * DM, (const bf16*)(ws + WS_WUP), DFF, DM, Es, lds, tid, lane, wave, bid, G); }
        pg8::Gemm g{H, (const bf16*)(ws + WS_WUP), NP, DFF, DM}; pg8::StaticOrder S; S.init(NP, DFF, G, bid);
        pg8::EpiRelu2 E{(bf16*)(ws + WS_HUP), DFF};
        pg8::gemm_phase<pg8::EpiRelu2, pg8::StaticOrder, true, true>(lds + RING_OFF, g, S, E);
        GRID_BAR();
    }
    if (IN(8)) { PHASE_IDS();
        { SkEpiResGate Es{args.out + (size_t)NP * DM, args.out + (size_t)NP * DM, ADA, 5120};
          skinny_gemm<1, 4, SkEpiResGate>((const bf16*)(ws + WS_HUP) + (size_t)NP * DFF, (const bf16*)(ws + WS_WDN), DM, DFF, Es, lds, tid, lane, wave, bid, G); }
        pg8::Gemm g{(const bf16*)(ws + WS_HUP), (const bf16*)(ws + WS_WDN), NP, DM, DFF}; pg8::StaticOrder S; S.init(NP, DM, G, bid);
        pg8::EpiResGate E{args.out, args.out + (size_t)NP * DM, args.out, ADA, 5120};
        pg8::gemm_phase<pg8::EpiResGate, pg8::StaticOrder, true, true>(lds + RING_OFF, g, S, E);
    }
#undef IN
#undef GRID_BAR
}

extern "C" void kernel_launch(void* const* d_in, const int* in_sizes, int n_in, void* d_out, int out_size, void* d_ws, size_t ws_size, hipStream_t stream) {
    static int grid = 0;
    if (grid == 0) {
        if (n_in != 21 || in_sizes[0] != NP * DM || out_size != (int)O_END || ws_size < WS_END) { fprintf(stderr, "kernel_launch: unexpected shapes (n_in %d, in0 %d, out %d, ws %zu); nothing launched\n", n_in, n_in > 0 ? in_sizes[0] : -1, out_size, ws_size); grid = -1; return; }
        int dev = 0, cus = 0, per_cu = 0;
        if (hipGetDevice(&dev) != hipSuccess || hipDeviceGetAttribute(&cus, hipDeviceAttributeMultiprocessorCount, dev) != hipSuccess) { fprintf(stderr, "kernel_launch: device query failed\n"); grid = -1; return; }
        if (hipFuncSetAttribute((const void*)hymba_fwd, hipFuncAttributeMaxDynamicSharedMemorySize, LDS_BYTES) != hipSuccess) { fprintf(stderr, "kernel_launch: hipFuncSetAttribute failed\n"); grid = -1; return; }
        if (hipOccupancyMaxActiveBlocksPerMultiprocessor(&per_cu, (const void*)hymba_fwd, NWAVES * 64, LDS_BYTES) != hipSuccess || per_cu < 1)
            fprintf(stderr, "kernel_launch: note: occupancy query reports %d workgroups per CU\n", per_cu);
        (void)hipGetLastError();
        grid = cus;
    }
    if (grid < 0) return;
    if (hipMemsetAsync((char*)d_ws + WS_CTL, 0, CTL_ZERO_BYTES, stream) != hipSuccess) { fprintf(stderr, "kernel_launch: memset failed\n"); return; }
    Args a{};
    for (int i = 0; i < 21; ++i) a.in[i] = (const float*)d_in[i];
    a.out = (float*)d_out; a.ws = (unsigned char*)d_ws;
    if (N_LAUNCHES == 1) { a.ph_lo = 0; a.ph_hi = NPHASE; hipLaunchKernelGGL(hymba_fwd, dim3(grid), dim3(NWAVES * 64), LDS_BYTES, stream, a); }
    else for (int li = 0; li < NPHASE; ++li) { a.ph_lo = li; a.ph_hi = li + 1; hipLaunchKernelGGL(hymba_fwd, dim3(grid), dim3(NWAVES * 64), LDS_BYTES, stream, a); }
    const hipError_t le = hipPeekAtLastError();
    if (le != hipSuccess) fprintf(stderr, "kernel_launch: launch failed: %s\n", hipGetErrorName(le));
}
```
